# Optimizing an MI355X kernel written in HIP

```python
import math
import jax, jax.numpy as jnp
from jax import lax
import numpy as np


D_MODEL = 2048
BATCH = 1
SEQ = 8192
DEPTH = 2

N_EVEN = (DEPTH + 1) // 2
N_ODD = DEPTH // 2
RMS_EPS = 1e-6

CONV_WIDTH = D_MODEL // 2
CONV_GROUPS = 8
CONV_K = 3
S5_WIDTH = D_MODEL // 2
S5_GROUP = 16
S5_GROUPS = S5_WIDTH // S5_GROUP
S5_STATE = 64
DT_MIN = 0.001
DT_MAX = 0.1
AB_IN_WIDTH = 3 * CONV_WIDTH + S5_WIDTH
FOX_HEADS = 16
FOX_HEAD_DIM = D_MODEL // FOX_HEADS
Q_BLOCK = 128
FORGET_BIAS_LO = 1.0
FORGET_BIAS_HI = 5.0
N_GROUPS = 4
EXPERTS_PER_GROUP = 8
TOP_K = 2
EXPERT_FF = 512

kernel_name = 'hybrid_conv_s5_fox_hmoe'


def rmsnorm(x, g):
    xf = x.astype(jnp.float32)
    y = xf * lax.rsqrt(jnp.mean(xf * xf, axis=-1, keepdims=True) + RMS_EPS)
    return (y * g.astype(jnp.float32)).astype(x.dtype)


def short_conv_mixer(gate_b, gate_c, u, conv_w):
    v = gate_c * u
    rhs = conv_w.astype(v.dtype)[:, None, :]
    conv = lax.conv_general_dilated(v, rhs, window_strides=(1,), padding=[(CONV_K - 1, 0)],
                                    dimension_numbers=('NWC', 'WIO', 'NWC'),
                                    feature_group_count=CONV_WIDTH)
    return gate_b * conv


def s5_mixer(u, lam_re, lam_im, log_dt, b_re, b_im, c_re, c_im, d, w_glu, b_glu):
    bsz, L, _ = u.shape
    f32 = jnp.float32
    uf = u.astype(f32).reshape(bsz, L, S5_GROUPS, S5_GROUP)
    lam = lax.complex(lam_re.astype(f32), lam_im.astype(f32))
    dt = jnp.exp(log_dt.astype(f32))[:, None]
    lam_bar = jnp.exp(lam * dt)
    bmat = lax.complex(b_re.astype(f32), b_im.astype(f32))
    b_bar = ((lam_bar - 1.0) / lam)[..., None] * bmat
    bu = jnp.einsum('gnh,blgh->blgn', b_bar, uf.astype(jnp.complex64))
    a = jnp.broadcast_to(lam_bar, bu.shape)

    def combine(e1, e2):
        a1, b1 = e1
        a2, b2 = e2
        return a2 * a1, a2 * b1 + b2

    _, states = lax.associative_scan(combine, (a, bu), axis=1)
    cmat = lax.complex(c_re.astype(f32), c_im.astype(f32))
    y = jnp.real(jnp.einsum('ghn,blgn->blgh', cmat, states))
    y = y + d.astype(f32).reshape(S5_GROUPS, S5_GROUP) * uf
    y = jax.nn.gelu(y.reshape(bsz, L, S5_WIDTH))
    y = y * jax.nn.sigmoid(y @ w_glu.astype(f32) + b_glu.astype(f32))
    return y.astype(u.dtype)


def forgetting_attention(q, k, v, cum):
    bsz, L, H, dh = q.shape
    nb = L // Q_BLOCK
    scale = dh ** -0.5
    qb = q.reshape(bsz, nb, Q_BLOCK, H, dh).transpose(1, 0, 2, 3, 4)
    cq = cum.reshape(bsz, nb, Q_BLOCK, H).transpose(1, 0, 3, 2)
    ck = cum.transpose(0, 2, 1)
    key_pos = jnp.arange(L)

    def block(args):
        i, qi, ci = args
        s = jnp.einsum('bqhd,bkhd->bhqk', qi, k, preferred_element_type=jnp.float32) * scale
        s = s + (ci[..., :, None] - ck[:, :, None, :])
        q_pos = i * Q_BLOCK + jnp.arange(Q_BLOCK)
        mask = key_pos[None, :] <= q_pos[:, None]
        s = jnp.where(mask, s, -jnp.inf)
        p = jax.nn.softmax(s, axis=-1)
        return jnp.einsum('bhqk,bkhd->bqhd', p.astype(v.dtype), v)

    out = lax.map(block, (jnp.arange(nb), qb, cq))
    return out.transpose(1, 0, 2, 3, 4).reshape(bsz, L, H * dh)


def hierarchical_moe(x, w_group, b_group, w_expert, b_expert, w_gate, w_up, w_down):
    bsz, L, D = x.shape
    t = x.reshape(-1, D)
    xf = t.astype(jnp.float32)
    gprob = jax.nn.softmax(xf @ w_group.astype(jnp.float32) + b_group.astype(jnp.float32), axis=-1)
    gw, gidx = lax.top_k(gprob, 1)
    elog = jnp.einsum('td,dge->tge', xf, w_expert.astype(jnp.float32)) + b_expert.astype(jnp.float32)
    elog = jnp.take_along_axis(elog, gidx[:, :, None], axis=1)[:, 0]
    ev, eidx = lax.top_k(elog, TOP_K)
    ew = jax.nn.softmax(ev, axis=-1) * gw
    comb = jnp.einsum('tk,tke->te', ew, jax.nn.one_hot(eidx, EXPERTS_PER_GROUP, dtype=jnp.float32))
    out = jnp.zeros((t.shape[0], D), jnp.float32)
    for g in range(N_GROUPS):
        cg = comb * (gidx == g).astype(jnp.float32)
        h = jax.nn.silu(jnp.einsum('td,edf->tef', t, w_gate[g])) * jnp.einsum('td,edf->tef', t, w_up[g])
        out = out + jnp.einsum('tef,efd->td', h * cg[..., None].astype(h.dtype), w_down[g],
                               preferred_element_type=jnp.float32)
    return out.astype(x.dtype).reshape(bsz, L, D)


def setup_inputs(seed: int = 0) -> dict:
    key = jax.random.key(seed)
    ks = list(jax.random.split(key, 32))
    f32 = jnp.float32

    def nrm(k, shape, scale):
        return jax.random.normal(k, shape, f32) * scale

    D = D_MODEL
    n = jnp.arange(S5_STATE, dtype=f32)
    inp = {}
    inp['x'] = nrm(ks[0], (BATCH, SEQ, D), 1.0)
    inp['ab_norm'] = 1.0 + nrm(ks[1], (N_EVEN, D), 0.01)
    inp['ab_w_in'] = nrm(ks[2], (N_EVEN, D, AB_IN_WIDTH), D ** -0.5)
    inp['ab_conv_w'] = nrm(ks[3], (N_EVEN, CONV_K, CONV_WIDTH), CONV_K ** -0.5)
    inp['s5_lambda_re'] = -0.5 + nrm(ks[4], (N_EVEN, S5_GROUPS, S5_STATE), 0.01)
    inp['s5_lambda_im'] = math.pi * n + nrm(ks[5], (N_EVEN, S5_GROUPS, S5_STATE), 0.01)
    inp['s5_log_dt'] = jax.random.uniform(ks[6], (N_EVEN, S5_GROUPS), f32, math.log(DT_MIN), math.log(DT_MAX))
    inp['s5_b_re'] = nrm(ks[7], (N_EVEN, S5_GROUPS, S5_STATE, S5_GROUP), (2 * S5_GROUP) ** -0.5)
    inp['s5_b_im'] = nrm(ks[8], (N_EVEN, S5_GROUPS, S5_STATE, S5_GROUP), (2 * S5_GROUP) ** -0.5)
    inp['s5_c_re'] = nrm(ks[9], (N_EVEN, S5_GROUPS, S5_GROUP, S5_STATE), (2 * S5_STATE) ** -0.5)
    inp['s5_c_im'] = nrm(ks[10], (N_EVEN, S5_GROUPS, S5_GROUP, S5_STATE), (2 * S5_STATE) ** -0.5)
    inp['s5_d'] = nrm(ks[11], (N_EVEN, S5_WIDTH), 1.0)
    inp['s5_w_glu'] = nrm(ks[12], (N_EVEN, S5_WIDTH, S5_WIDTH), S5_WIDTH ** -0.5)
    inp['s5_b_glu'] = nrm(ks[13], (N_EVEN, S5_WIDTH), 0.01)
    inp['ab_w_out'] = nrm(ks[14], (N_EVEN, CONV_WIDTH + S5_WIDTH, D), (CONV_WIDTH + S5_WIDTH) ** -0.5)
    inp['c_norm'] = 1.0 + nrm(ks[15], (N_ODD, D), 0.01)
    inp['c_w_in'] = nrm(ks[16], (N_ODD, D, 3 * D + FOX_HEADS), D ** -0.5)
    inp['c_b_forget'] = jax.random.uniform(ks[17], (N_ODD, FOX_HEADS), f32, FORGET_BIAS_LO, FORGET_BIAS_HI)
    inp['c_w_out'] = nrm(ks[18], (N_ODD, D, D), D ** -0.5)
    inp['ffn_norm'] = 1.0 + nrm(ks[19], (DEPTH, D), 0.01)
    inp['router_w_group'] = nrm(ks[20], (DEPTH, D, N_GROUPS), D ** -0.5)
    inp['router_b_group'] = nrm(ks[21], (DEPTH, N_GROUPS), 0.01)
    inp['router_w_expert'] = nrm(ks[22], (DEPTH, D, N_GROUPS, EXPERTS_PER_GROUP), D ** -0.5)
    inp['router_b_expert'] = nrm(ks[23], (DEPTH, N_GROUPS, EXPERTS_PER_GROUP), 0.01)
    inp['moe_w_gate'] = nrm(ks[24], (DEPTH, N_GROUPS, EXPERTS_PER_GROUP, D, EXPERT_FF), D ** -0.5)
    inp['moe_w_up'] = nrm(ks[25], (DEPTH, N_GROUPS, EXPERTS_PER_GROUP, D, EXPERT_FF), D ** -0.5)
    inp['moe_w_down'] = nrm(ks[26], (DEPTH, N_GROUPS, EXPERTS_PER_GROUP, EXPERT_FF, D), EXPERT_FF ** -0.5)
    inp['final_norm'] = 1.0 + nrm(ks[27], (D,), 0.01)
    return inp


def reference(x, ab_norm, ab_w_in, ab_conv_w, s5_lambda_re, s5_lambda_im, s5_log_dt, s5_b_re, s5_b_im,
              s5_c_re, s5_c_im, s5_d, s5_w_glu, s5_b_glu, ab_w_out, c_norm, c_w_in, c_b_forget, c_w_out,
              ffn_norm, router_w_group, router_b_group, router_w_expert, router_b_expert,
              moe_w_gate, moe_w_up, moe_w_down, final_norm):
    bsz, L, D = x.shape
    cw = CONV_WIDTH
    for i in range(DEPTH):
        j = i // 2
        if i % 2 == 0:
            h = rmsnorm(x, ab_norm[j])
            proj = h @ ab_w_in[j]
            gate_b = proj[..., :cw]
            gate_c = proj[..., cw:2 * cw]
            u_conv = proj[..., 2 * cw:3 * cw]
            u_ssm = proj[..., 3 * cw:]
            y_conv = short_conv_mixer(gate_b, gate_c, u_conv, ab_conv_w[j])
            y_ssm = s5_mixer(u_ssm, s5_lambda_re[j], s5_lambda_im[j], s5_log_dt[j], s5_b_re[j], s5_b_im[j],
                             s5_c_re[j], s5_c_im[j], s5_d[j], s5_w_glu[j], s5_b_glu[j])
            x = x + jnp.concatenate([y_conv, y_ssm], axis=-1) @ ab_w_out[j]
        else:
            h = rmsnorm(x, c_norm[j])
            proj = h @ c_w_in[j]
            q = proj[..., :D].reshape(bsz, L, FOX_HEADS, FOX_HEAD_DIM)
            k = proj[..., D:2 * D].reshape(bsz, L, FOX_HEADS, FOX_HEAD_DIM)
            v = proj[..., 2 * D:3 * D].reshape(bsz, L, FOX_HEADS, FOX_HEAD_DIM)
            log_f = jax.nn.log_sigmoid(proj[..., 3 * D:].astype(jnp.float32) + c_b_forget[j].astype(jnp.float32))
            cum = jnp.cumsum(log_f, axis=1)
            x = x + forgetting_attention(q, k, v, cum) @ c_w_out[j]
        h = rmsnorm(x, ffn_norm[i])
        x = x + hierarchical_moe(h, router_w_group[i], router_b_group[i], router_w_expert[i],
                                 router_b_expert[i], moe_w_gate[i], moe_w_up[i], moe_w_down[i])
    return rmsnorm(x, final_norm)
```

```cpp
#include <hip/hip_runtime.h>
#include <stdint.h>
#include <stdio.h>

namespace mk {
#define LAS __attribute__((address_space(3)))
#define GAS __attribute__((address_space(1)))
typedef unsigned short bf16_t;
typedef short bf16x8 __attribute__((ext_vector_type(8)));
typedef short s16x4 __attribute__((ext_vector_type(4)));
typedef float f32x4 __attribute__((ext_vector_type(4)));
typedef float f32x2 __attribute__((ext_vector_type(2)));
typedef float f32x16 __attribute__((ext_vector_type(16)));
typedef unsigned u32x4 __attribute__((ext_vector_type(4)));
typedef unsigned u32x2 __attribute__((ext_vector_type(2)));

constexpr int T = 8192, D = 2048;
constexpr int CW = 1024, SW = 1024, SG = 64, SH = 16, SN = 64;
constexpr int LC = 32, NC = T / LC;
constexpr int S5K = LC * SH + 2 * SN;
constexpr int NH = 16, DH = 128;
constexpr int NE = 32, FF = 512;
constexpr int NWAVES = 8;
constexpr float EPS = 1e-6f;

constexpr size_t MiB = 1u << 20;
constexpr size_t WS_CTL = 0, CTL_BYTES = 1 * MiB;
constexpr size_t WS_WIN0 = 2 * MiB;
constexpr size_t WS_WGLU = 18 * MiB;
constexpr size_t WS_WOUT0 = 20 * MiB;
constexpr size_t WS_WIN1 = 28 * MiB;
constexpr size_t WS_WOUT1 = 52 * MiB;
constexpr size_t WS_WR = 60 * MiB;
constexpr size_t WS_WF = 61 * MiB;
constexpr size_t WS_LAM = 61 * MiB + 512 * 1024;
constexpr size_t WS_TZ = 62 * MiB;
constexpr size_t WS_MB = 102 * MiB;
constexpr size_t WS_WGU = 118 * MiB;
constexpr size_t WS_WD = 374 * MiB;
constexpr size_t WS_XB = 502 * MiB;
constexpr size_t WS_XA = 534 * MiB;
constexpr size_t WS_XBB = 598 * MiB;
constexpr size_t WS_R = 662 * MiB;
constexpr size_t WS_PROJ = 663 * MiB;
constexpr size_t WS_S5A = 711 * MiB;
constexpr size_t WS_S = 731 * MiB;
constexpr size_t WS_YG = 739 * MiB;
constexpr size_t WS_CAT = 755 * MiB;
constexpr size_t WS_QKV = 787 * MiB;
constexpr size_t WS_H = 883 * MiB;
constexpr size_t WS_Y = 900 * MiB;
constexpr size_t WS_LIST = 964 * MiB;
constexpr size_t WS_PW = 965 * MiB;
constexpr size_t WS_LOGF = 966 * MiB;
constexpr size_t WS_CKS = 967 * MiB;
constexpr size_t WS_END = 968 * MiB;
constexpr int CW_BAR = 4096;
constexpr int CW_CNT = 1024;
constexpr int MAX_LAUNCH = 24;

constexpr int RING_BYTES = 131072;
constexpr int LDSCTL_OFF = RING_BYTES, MISC_OFF = LDSCTL_OFF + 320;
constexpr int LDS_BYTES = 147456;

#define LDS_WAIT() asm volatile("s_waitcnt lgkmcnt(0)" ::: "memory")
#define VM_WAIT() asm volatile("s_waitcnt vmcnt(0)" ::: "memory")

__device__ __forceinline__ unsigned cvt_pk_bf16(float lo, float hi) { unsigned r; asm volatile("v_cvt_pk_bf16_f32 %0, %1, %2" : "=v"(r) : "v"(lo), "v"(hi)); return r; }
__device__ __forceinline__ float bf2f(unsigned short b) { return __uint_as_float(((unsigned)b) << 16); }
__device__ __forceinline__ float bflo(unsigned w) { return __uint_as_float(w << 16); }
__device__ __forceinline__ float bfhi(unsigned w) { return __uint_as_float(w & 0xffff0000u); }
__device__ __forceinline__ float wave_sum(float v) {
#pragma unroll
    for (int o = 1; o < 64; o <<= 1) v += __shfl_xor(v, o);
    return v;
}
__device__ __forceinline__ float gelu_tanh_f(float y) {
    const float u = 0.7978845608028654f * (y + 0.044715f * y * y * y);
    return y / (1.f + __expf(-2.f * u));
}
__device__ __forceinline__ float sigmoid_f(float z) { return 1.f / (1.f + __expf(-z)); }

#define XB_TMO      128
#define XB_XCNT(j)  (256  + 64 * (j))
#define XB_XSUB(j)  (1280 + 64 * (j))
#define XB_XGEN(j)  (2304 + 64 * (j))
#define XB_TOP      3328
#define XB_TOPGEN   3392
#define XCD_BAR_WORDS 3456
#define XB_SPIN_CAP (1u << 18)
__device__ __forceinline__ unsigned xb_ld(unsigned* p)              { return __hip_atomic_load(p, __ATOMIC_RELAXED, __HIP_MEMORY_SCOPE_AGENT); }
__device__ __forceinline__ unsigned xb_add(unsigned* p, unsigned v) { return __hip_atomic_fetch_add(p, v, __ATOMIC_RELAXED, __HIP_MEMORY_SCOPE_AGENT); }
__device__ __forceinline__ unsigned xb_xcc_id() { return (unsigned)__builtin_amdgcn_s_getreg((3 << 11) | 20) & 0xFu; }
#define XB_SPIN(cond, bar) do { unsigned _sp = 0; while (cond) { __builtin_amdgcn_s_sleep(1); \
    if ((++_sp & 255u) == 0u) { if (xb_ld(&(bar)[XB_TMO])) break; if (_sp > XB_SPIN_CAP) { atomicAdd(&(bar)[XB_TMO], 1u); break; } } } } while (0)
struct XcdBarrier { unsigned* bar; unsigned x; volatile LAS unsigned* st; };
__device__ __forceinline__ XcdBarrier xcd_barrier_post(unsigned* bar, volatile LAS unsigned* st) {
    XcdBarrier b; b.bar = bar; b.x = xb_xcc_id(); b.st = st;
    if (threadIdx.x == 0) (void)xb_add(&bar[XB_XCNT(b.x)], 1u);
    return b;
}
__device__ __forceinline__ void xcd_barrier_complete(unsigned* bar, unsigned x, unsigned& nloc, unsigned& nx) {
    const unsigned G = gridDim.x * gridDim.y * gridDim.z;
    unsigned sum, cnt, mine, sp = 0u;
    for (;;) {
        sum = 0u; cnt = 0u; mine = 0u;
#pragma unroll
        for (unsigned j = 0; j < 16; ++j) { const unsigned c = xb_ld(&bar[XB_XCNT(j)]); sum += c; cnt += (c > 0u) ? 1u : 0u; mine = (j == x) ? c : mine; }
        if (sum == G) break;
        __builtin_amdgcn_s_sleep(1);
        if ((++sp & 255u) == 0u) { if (xb_ld(&bar[XB_TMO])) break; if (sp > XB_SPIN_CAP) { atomicAdd(&bar[XB_TMO], 1u); break; } }
    }
    nloc = mine > 0u ? mine : 1u; nx = cnt > 0u ? cnt : 1u;
}
__device__ __forceinline__ void xcd_barrier(const XcdBarrier& b) {
    asm volatile("s_waitcnt vmcnt(0)" ::: "memory");
    __syncthreads();
    if (threadIdx.x == 0) {
        unsigned* bar = b.bar;
        __builtin_amdgcn_s_waitcnt(0);
        unsigned nloc = b.st[0], nx = b.st[1];
        if (nloc == 0u) { xcd_barrier_complete(bar, b.x, nloc, nx); b.st[0] = nloc; b.st[1] = nx; }
        const unsigned old = xb_add(&bar[XB_XSUB(b.x)], 1u);
        const unsigned gen = old / nloc;
        if (old + 1u == (gen + 1u) * nloc) {
            __builtin_amdgcn_fence(__ATOMIC_RELEASE, "agent");
            asm volatile("s_waitcnt vmcnt(0)" ::: "memory");
            const unsigned og = xb_add(&bar[XB_TOP], 1u);
            const unsigned tg = og / nx;
            if (og + 1u == (tg + 1u) * nx) xb_add(&bar[XB_TOPGEN], 1u);
            else XB_SPIN(xb_ld(&bar[XB_TOPGEN]) == tg, bar);
            __builtin_amdgcn_fence(__ATOMIC_ACQUIRE, "agent");
            xb_add(&bar[XB_XGEN(b.x)], 1u);
            asm volatile("s_waitcnt vmcnt(0)" ::: "memory");
        } else {
            XB_SPIN(xb_ld(&bar[XB_XGEN(b.x)]) == gen, bar);
            __builtin_amdgcn_fence(__ATOMIC_ACQUIRE, "agent");
            asm volatile("s_waitcnt vmcnt(0)" ::: "memory");
        }
    }
    __syncthreads();
}

constexpr int BM = 256, BK = 64, HALF = 128, HTB = HALF * BK * 2, STAGE_BYTES = 8 * HTB, NXCD = 8, WGM = 8;
__host__ __device__ __forceinline__ int lds_byte(int r, int c) { const int st = (r >> 4) * 2 + (c >> 5), rr = r & 15, cc = c & 31, ob = rr * 64 + cc * 2; return st * 1024 + (ob ^ (((ob >> 9) & 1) << 5)); }
__host__ __device__ __forceinline__ void stage_rc(int b, int& R, int& C) { const int st = b / 1024, sb = b % 1024, swz = sb ^ (((sb >> 9) & 1) << 5); R = (st >> 1) * 16 + swz / 64; C = (st & 1) * 32 + (swz % 64) / 2; }
__host__ __device__ __forceinline__ int perm32(int rho) { const int n = rho >> 4, i = rho & 15; return 8 * (i >> 2) + 4 * n + (i & 3); }

struct Unit {
    const char* A;
    const char* B;
    const int* rows;
    int pm, pn, e, nvalid, aux;
};
struct ARow { int lda2; static constexpr bool PER_UNIT = false;
    __device__ __forceinline__ unsigned voff(const Unit&, int R, int C) const { return (unsigned)(R * lda2 + C * 2); }
    __device__ __forceinline__ size_t kstep() const { return 128; } };
struct AGather { int lda2; static constexpr bool PER_UNIT = true;
    __device__ __forceinline__ unsigned voff(const Unit& u, int R, int C) const { const int idx = R < u.nvalid ? R : 0; const int row = u.rows[idx] >> 1; return (unsigned)(row * lda2 + C * 2); }
    __device__ __forceinline__ size_t kstep() const { return 128; } };
struct AGroupMajor { static constexpr bool PER_UNIT = false;
    __device__ __forceinline__ unsigned voff(const Unit&, int R, int C) const { return (unsigned)((((C >> 4) * T + R) * 16 + (C & 15)) * 2); }
    __device__ __forceinline__ size_t kstep() const { return (size_t)4 * T * 16 * 2; } };

struct DenseOrder {
    const char* A; const char* B; size_t astep, bstep; int nM, nN, nwg, G, c;
    __device__ __forceinline__ void init(const void* A_, size_t astep_, const void* B_, size_t bstep_, int M, int N, int G_, int c_) {
        A = (const char*)A_; B = (const char*)B_; astep = astep_; bstep = bstep_; nM = M / BM; nN = N / BM; nwg = nM * nN; G = G_; c = c_; }
    __device__ __forceinline__ bool next(int i, Unit& u) const {
        const long L = (long)i * G + c; if (L >= nwg) return false;
        int wgid = (int)L; { const int q = nwg / NXCD, r = nwg % NXCD, xcd = wgid % NXCD, off = wgid / NXCD; wgid = (xcd < r ? xcd * (q + 1) : r * (q + 1) + (xcd - r) * q) + off; }
        const int nig = WGM * nN, gid = wgid / nig, fm = gid * WGM, gsz = (nM - fm) < WGM ? (nM - fm) : WGM;
        u.pm = fm + ((wgid % nig) % gsz); u.pn = (wgid % nig) / gsz; u.e = 0; u.nvalid = BM; u.rows = nullptr; u.aux = 0;
        u.A = A + (size_t)u.pm * astep; u.B = B + (size_t)u.pn * bstep; return true;
    }
};
struct BatchOrder {
    const char* A; const char* B; size_t abatch, bbatch, bstep; int nN, nwg, G, c;
    __device__ __forceinline__ bool next(int i, Unit& u) const {
        const long L = (long)i * G + c; if (L >= nwg) return false;
        u.e = (int)L / nN; u.pn = (int)L % nN; u.pm = 0; u.nvalid = BM; u.rows = nullptr; u.aux = 0;
        u.A = A + (size_t)u.e * abatch; u.B = B + (size_t)u.e * bbatch + (size_t)u.pn * bstep; return true;
    }
};

template <class AL, class Epi, class Sched, bool ALIGN_EPI, bool RAGGED>
__device__ __forceinline__ void gemm_phase(LAS unsigned char* lds, const int K, const AL al, const Sched& S, const Epi& E) {
    const int tid = threadIdx.x, wid = __builtin_amdgcn_readfirstlane(tid >> 6), lane = tid & 63, wr = wid >> 2, wc = wid & 3, fr = lane & 15, fq = lane >> 4;
    const int nt = K / BK;
    unsigned voffB[2];
#pragma unroll
    for (int i = 0; i < 2; ++i) { int R, C; stage_rc(tid * 16 + i * 8192, R, C); const int Rb = Epi::PERM ? ((R & ~31) + perm32(R & 31)) : R; voffB[i] = (unsigned)(Rb * K + C) * 2u; }
    const size_t kstepA = al.kstep(), kstepB = (size_t)(BK * 2), hstepB = (size_t)HALF * K * 2;
    const unsigned ldsw = (unsigned)wid * 1024u;
    const int aoff = lds_byte(wr * 64 + fr, fq * 8), boff = lds_byte(wc * 32 + fr, fq * 8);
#define PG_SA(b, h) (((b) * 2 + (h)) * HTB)
#define PG_SB(b, h) ((4 + (b) * 2 + (h)) * HTB)
#define PG_STG(bufoff, gbase, v0, v1) do { \
        __builtin_amdgcn_global_load_lds((const unsigned*)((const char*)(gbase) + (v0)), (LAS unsigned*)(lds + (bufoff) + ldsw), 16, 0, 0); \
        __builtin_amdgcn_global_load_lds((const unsigned*)((const char*)(gbase) + (v1)), (LAS unsigned*)(lds + (bufoff) + ldsw + 8192), 16, 0, 0); } while (0)
#define PG_STGB(bufoff, gbase) PG_STG(bufoff, gbase, voffB[0], voffB[1])
#define PG_LDA(dst, b, h) do { _Pragma("unroll") for (int m = 0; m < 4; ++m) _Pragma("unroll") for (int k = 0; k < 2; ++k) dst[m][k] = *(const LAS bf16x8*)(lds + PG_SA(b, h) + aoff + m * 2048 + k * 1024); } while (0)
#define PG_LDB(dst, b, h) do { _Pragma("unroll") for (int n = 0; n < 2; ++n) _Pragma("unroll") for (int k = 0; k < 2; ++k) dst[n][k] = *(const LAS bf16x8*)(lds + PG_SB(b, h) + boff + n * 2048 + k * 1024); } while (0)
#define PG_MMA(ai, bj, At, Bt) do { __builtin_amdgcn_s_setprio(1); _Pragma("unroll") for (int m = 0; m < 4; ++m) _Pragma("unroll") for (int n = 0; n < 2; ++n) _Pragma("unroll") for (int k = 0; k < 2; ++k) \
        acc[ai][bj][m][n] = __builtin_amdgcn_mfma_f32_16x16x32_bf16(Bt[n][k], At[m][k], acc[ai][bj][m][n], 0, 0, 0); __builtin_amdgcn_s_setprio(0); } while (0)
#define PG_WAIT_V(n) asm volatile("s_waitcnt vmcnt(" #n ")" ::: "memory")
#define PG_WAIT_L(n) asm volatile("s_waitcnt lgkmcnt(" #n ")" ::: "memory")
#define PG_BAR __builtin_amdgcn_s_barrier()
#define PG_SCHED __builtin_amdgcn_sched_barrier(0)
    Unit cur, nxt; int ui = 0;
    if (!S.next(0, cur)) return;
    unsigned vA[2][2];
#pragma unroll
    for (int h = 0; h < 2; ++h)
#pragma unroll
        for (int i = 0; i < 2; ++i) { int R, C; stage_rc((int)threadIdx.x * 16 + i * 8192, R, C); vA[h][i] = al.voff(cur, h * HALF + R, C); }
    f32x4 acc[2][2][4][2];
#pragma unroll
    for (int a = 0; a < 2; ++a)
#pragma unroll
        for (int b = 0; b < 2; ++b)
#pragma unroll
            for (int m = 0; m < 4; ++m)
#pragma unroll
                for (int n = 0; n < 2; ++n) acc[a][b][m][n] = (f32x4){0.f, 0.f, 0.f, 0.f};
    bf16x8 At[4][2], B0[2][2], B1[2][2];
    const char* cA = cur.A; const char* cB = cur.B;
    PG_STGB(PG_SB(0, 0), cB); PG_STGB(PG_SB(0, 1), cB + hstepB); PG_STG(PG_SA(0, 0), cA, vA[0][0], vA[0][1]); PG_STG(PG_SA(0, 1), cA, vA[1][0], vA[1][1]);
    if (wr == 1) PG_BAR;
    PG_WAIT_V(2); PG_BAR;
    PG_STGB(PG_SB(1, 0), cB + kstepB); PG_STG(PG_SA(1, 0), cA + kstepA, vA[0][0], vA[0][1]); PG_STGB(PG_SB(1, 1), cB + hstepB + kstepB);
    PG_WAIT_V(6); PG_BAR;
    for (;;) {
        const bool has_next = S.next(ui + 1, nxt);
        const char* nA = has_next ? nxt.A : cA; const char* nB = has_next ? nxt.B : cB;
        for (int t = 0; t < nt; t += 2) {
            const bool last = (t == nt - 2);
            const char* a1 = cA + (size_t)(t + 1) * kstepA;
            const char* a2 = last ? nA : cA + (size_t)(t + 2) * kstepA; const char* b2 = last ? nB : cB + (size_t)(t + 2) * kstepB;
            const char* a3 = a2 + kstepA; const char* b3 = b2 + kstepB;
            const bool up = !RAGGED || cur.nvalid > HALF;
            PG_LDB(B0, 0, 0); PG_LDB(B1, 0, 1); PG_SCHED; PG_LDA(At, 0, 0); PG_STG(PG_SA(1, 1), a1, vA[1][0], vA[1][1]);
            if constexpr (AL::PER_UNIT) {
                if (last && has_next) {
#pragma unroll
                    for (int h = 0; h < 2; ++h)
#pragma unroll
                        for (int i = 0; i < 2; ++i) { int R, C; stage_rc((int)threadIdx.x * 16 + i * 8192, R, C); vA[h][i] = al.voff(nxt, h * HALF + R, C); }
                }
            }
            PG_WAIT_V(8); PG_WAIT_L(0); PG_BAR; PG_MMA(0, 0, At, B0); PG_MMA(0, 1, At, B1); PG_BAR; PG_SCHED;
            PG_LDA(At, 0, 1); PG_STGB(PG_SB(0, 0), b2); PG_STGB(PG_SB(0, 1), b2 + hstepB); PG_STG(PG_SA(0, 0), a2, vA[0][0], vA[0][1]);
            PG_WAIT_V(8); PG_WAIT_L(0); PG_BAR; if (up) { PG_MMA(1, 0, At, B0); PG_MMA(1, 1, At, B1); } PG_BAR; PG_SCHED;
            PG_LDB(B0, 1, 0); PG_LDB(B1, 1, 1); PG_SCHED; PG_LDA(At, 1, 0); PG_STG(PG_SA(0, 1), a2, vA[1][0], vA[1][1]);
            PG_WAIT_V(8); PG_WAIT_L(0); PG_BAR; PG_MMA(0, 0, At, B0); PG_MMA(0, 1, At, B1); PG_BAR; PG_SCHED;
            PG_LDA(At, 1, 1); PG_STGB(PG_SB(1, 0), b3); PG_STGB(PG_SB(1, 1), b3 + hstepB); PG_STG(PG_SA(1, 0), a3, vA[0][0], vA[0][1]);
            PG_WAIT_V(8); PG_WAIT_L(0); PG_BAR; if (up) { PG_MMA(1, 0, At, B0); PG_MMA(1, 1, At, B1); } PG_BAR; PG_SCHED;
        }
        if constexpr (ALIGN_EPI) { if (wr == 0) PG_BAR; }
        E(acc, cur, wr, wc, fr, fq);
        if (!has_next) break;
#pragma unroll
        for (int a = 0; a < 2; ++a)
#pragma unroll
            for (int b = 0; b < 2; ++b)
#pragma unroll
                for (int m = 0; m < 4; ++m)
#pragma unroll
                    for (int n = 0; n < 2; ++n) acc[a][b][m][n] = (f32x4){0.f, 0.f, 0.f, 0.f};
        cur = nxt; cA = nA; cB = nB; ++ui;
        if constexpr (ALIGN_EPI) { if (wr == 1) PG_BAR; }
    }
    PG_WAIT_V(0);
    if constexpr (!ALIGN_EPI) { if (wr == 0) PG_BAR; }
    PG_BAR;
#undef PG_SA
#undef PG_SB
#undef PG_STG
#undef PG_STGB
#undef PG_LDA
#undef PG_LDB
#undef PG_MMA
#undef PG_WAIT_V
#undef PG_WAIT_L
#undef PG_BAR
#undef PG_SCHED
}

struct Args { const float* in[28]; float* out; unsigned char* ws; int ph_lo, ph_hi, li, flags; };
struct Frame {
    LAS unsigned char* lds; volatile LAS unsigned* MISC; unsigned* ctl; unsigned char* ws;
    int tid, lane, wave, vcu, G;
};

template <bool GAIN, class RowMap>
__device__ __forceinline__ void tr_item(const float* W, int ldw, int K, bf16_t* WT, const float* gain, LAS float* scr, int kb, int nb, int lane, RowMap rm) {
    const int k0 = 64 * kb, n0 = 32 * nb;
    float gv = 1.f; if constexpr (GAIN) gv = gain[k0 + lane];
#pragma unroll 8
    for (int i = 0; i < 32; ++i) { const int kk = 2 * i + (lane >> 5); float v = W[(size_t)(k0 + kk) * ldw + n0 + (lane & 31)]; if constexpr (GAIN) v *= __shfl(gv, kk); scr[kk * 33 + (lane & 31)] = v; }
    LDS_WAIT(); asm volatile("" ::: "memory");
    const int c = lane & 7;
#pragma unroll
    for (int j = 0; j < 4; ++j) { const int n = (lane >> 3) + 8 * j; const LAS float* s = scr + (8 * c) * 33 + n;
        u32x4 o; o.x = cvt_pk_bf16(s[0 * 33], s[1 * 33]); o.y = cvt_pk_bf16(s[2 * 33], s[3 * 33]); o.z = cvt_pk_bf16(s[4 * 33], s[5 * 33]); o.w = cvt_pk_bf16(s[6 * 33], s[7 * 33]);
        *(u32x4*)(WT + (size_t)rm(n0 + n) * K + k0 + 8 * c) = o; }
    LDS_WAIT(); asm volatile("" ::: "memory");
}
struct RmId { __device__ __forceinline__ int operator()(int n) const { return n; } };
struct RmGU { int up; __device__ __forceinline__ int operator()(int n) const { return ((n >> 7) << 8) + up * 128 + (n & 127); } };

constexpr int PF_L0 = 1, PF_S5 = 2, PF_L1 = 4, PF_MOE = 8, PF_ALL = 15;

__device__ __forceinline__ void p0_weights(Frame& F, const Args& a) {
    LAS float* scr = (LAS float*)(F.lds + F.wave * 16384);
    const int gw = F.vcu * NWAVES + F.wave, NGW = F.G * NWAVES;
    bf16_t* win0 = (bf16_t*)(F.ws + WS_WIN0); bf16_t* wglu = (bf16_t*)(F.ws + WS_WGLU); bf16_t* wout0 = (bf16_t*)(F.ws + WS_WOUT0);
    bf16_t* win1 = (bf16_t*)(F.ws + WS_WIN1); bf16_t* wout1 = (bf16_t*)(F.ws + WS_WOUT1); bf16_t* wgu = (bf16_t*)(F.ws + WS_WGU); bf16_t* wd = (bf16_t*)(F.ws + WS_WD);
    constexpr int I_IN0 = (D / 64) * (4096 / 32), I_GLU = (SW / 64) * (SW / 32), I_OUT = (D / 64) * (D / 32), I_IN1 = (D / 64) * (6144 / 32);
    constexpr int I_G = (D / 64) * (FF / 32)  , I_D = (FF / 64) * (D / 32)  ;
    const int n_l0 = (a.flags & PF_L0) ? (I_IN0 + I_GLU + I_OUT) : 0;
    const int n_l1 = (a.flags & PF_L1) ? (I_IN1 + I_OUT) : 0;
    const int n_moe = (a.flags & PF_MOE) ? (64 * (2 * I_G + I_D)) : 0;
    const int total = n_l0 + n_l1 + n_moe;
    for (int it = gw; it < total; it += NGW) {
        int r = it;
        if (r < n_l0) {
            if (r < I_IN0) { tr_item<true>(a.in[2], 4096, D, win0, a.in[1], scr, r / 128, r % 128, F.lane, RmId{}); continue; } r -= I_IN0;
            if (r < I_GLU) { tr_item<false>(a.in[12], SW, SW, wglu, nullptr, scr, r / 32, r % 32, F.lane, RmId{}); continue; } r -= I_GLU;
            tr_item<false>(a.in[14], D, D, wout0, nullptr, scr, r / 64, r % 64, F.lane, RmId{}); continue;
        }
        r -= n_l0;
        if (r < n_l1) {
            if (r < I_IN1) { tr_item<true>(a.in[16], 3 * D + NH, D, win1, a.in[15], scr, r / 192, r % 192, F.lane, RmId{}); continue; } r -= I_IN1;
            tr_item<false>(a.in[18], D, D, wout1, nullptr, scr, r / 64, r % 64, F.lane, RmId{}); continue;
        }
        r -= n_l1;
        {
            const int le = r / (2 * I_G + I_D); int q = r % (2 * I_G + I_D); const int layer = le >> 5;
            const float* gain = a.in[19] + (size_t)layer * D;
            if (q < I_G) { tr_item<true>(a.in[24] + (size_t)le * D * FF, FF, D, wgu + (size_t)le * 1024 * D, gain, scr, q / 16, q % 16, F.lane, RmGU{0}); continue; } q -= I_G;
            if (q < I_G) { tr_item<true>(a.in[25] + (size_t)le * D * FF, FF, D, wgu + (size_t)le * 1024 * D, gain, scr, q / 16, q % 16, F.lane, RmGU{1}); continue; } q -= I_G;
            tr_item<false>(a.in[26] + (size_t)le * FF * D, D, FF, wd + (size_t)le * D * FF, nullptr, scr, q / 64, q % 64, F.lane, RmId{});
        }
    }
}
__device__ __forceinline__ void p0_rows(Frame& F, const float* x) {
    const int gw = F.vcu * NWAVES + F.wave, NGW = F.G * NWAVES;
    bf16_t* xb = (bf16_t*)(F.ws + WS_XB); float* rr = (float*)(F.ws + WS_R);
    for (int m = gw; m < T; m += NGW) {
        const f32x4* xr = (const f32x4*)(x + (size_t)m * D) + F.lane;
        f32x4 v[8]; float s = 0.f;
#pragma unroll
        for (int j = 0; j < 8; ++j) { v[j] = xr[64 * j]; s += (v[j].x * v[j].x + v[j].y * v[j].y) + (v[j].z * v[j].z + v[j].w * v[j].w); }
        s = wave_sum(s);
        u32x2* o = (u32x2*)(xb + (size_t)m * D) + F.lane;
#pragma unroll
        for (int j = 0; j < 8; ++j) { u32x2 w; w.x = cvt_pk_bf16(v[j].x, v[j].y); w.y = cvt_pk_bf16(v[j].z, v[j].w); o[64 * j] = w; }
        if (F.lane == 0) rr[m] = rsqrtf(s * (1.f / D) + EPS);
    }
}

struct EpiG1 {
    static constexpr bool PERM = true;
    bf16_t* proj; bf16_t* s5a; const float* rr;
    __device__ __forceinline__ void operator()(const f32x4 (&acc)[2][2][4][2], const Unit& u, int wr, int wc, int fr, int fq) const {
        const int row0 = u.pm * BM + wr * 64 + fr, col0 = u.pn * BM + wc * 32 + 8 * fq;
#pragma unroll
        for (int ai = 0; ai < 2; ++ai)
#pragma unroll
            for (int m = 0; m < 4; ++m) {
                const int row = row0 + ai * HALF + m * 16; const float sc = rr[row];
#pragma unroll
                for (int bj = 0; bj < 2; ++bj) {
                    const f32x4 v0 = acc[ai][bj][m][0] * sc, v1 = acc[ai][bj][m][1] * sc;
                    u32x4 w; w.x = cvt_pk_bf16(v0[0], v0[1]); w.y = cvt_pk_bf16(v0[2], v0[3]); w.z = cvt_pk_bf16(v1[0], v1[1]); w.w = cvt_pk_bf16(v1[2], v1[3]);
                    const int col = col0 + bj * HALF;
                    if (u.pn < 12) *(u32x4*)(proj + (size_t)row * 3072 + col) = w;
                    else { const int cc = col - 3072, g = cc >> 4, h0 = cc & 15, c = row >> 5, j = row & 31;
                           *(u32x4*)(s5a + ((size_t)(g * NC + c)) * S5K + j * 16 + h0) = w; }
                }
            }
    }
};


__device__ __forceinline__ void p0_s5_tables(Frame& F, const Args& a) {
    LAS float* pwr = (LAS float*)F.lds;
    LAS float* pwi = pwr + 64 * 33;
    LAS float* bbr = pwi + 64 * 33;
    LAS float* bbi = bbr + 64 * 16;
    LAS float* ctr = bbi + 64 * 16;
    LAS float* cti = ctr + 64 * 16;
    LAS float* Kt  = cti + 64 * 16;
    bf16_t* tz = (bf16_t*)(F.ws + WS_TZ); bf16_t* mb = (bf16_t*)(F.ws + WS_MB); float* lam32 = (float*)(F.ws + WS_LAM);
    const int tid = F.tid;
    for (int item = blockIdx.x; item < SG * 4; item += F.G) {
        const int g = item >> 2, q = item & 3;
        __syncthreads();
        const float dt = __expf(a.in[6][g]);
        for (int idx = tid; idx < 64 * 33; idx += NWAVES * 64) {
            const int n = idx / 33, tau = idx % 33;
            const float lr = a.in[4][g * SN + n], li = a.in[5][g * SN + n];
            const float mag = expf(lr * dt * (float)tau), ang = li * dt * (float)tau;
            pwr[idx] = mag * cosf(ang); pwi[idx] = mag * sinf(ang);
        }
        for (int idx = tid; idx < 64 * 16; idx += NWAVES * 64) {
            const int n = idx >> 4, h = idx & 15;
            const float lr = a.in[4][g * SN + n], li = a.in[5][g * SN + n];
            const float er = expf(lr * dt), ar = er * cosf(li * dt), ai = er * sinf(li * dt);
            const float nr = ar - 1.f, ni = ai, den = lr * lr + li * li;
            const float cr = (nr * lr + ni * li) / den, ci = (ni * lr - nr * li) / den;
            const float xr = a.in[7][((size_t)g * SN + n) * SH + h], xi = a.in[8][((size_t)g * SN + n) * SH + h];
            bbr[idx] = cr * xr - ci * xi; bbi[idx] = cr * xi + ci * xr;
            ctr[idx] = a.in[9][((size_t)g * SH + h) * SN + n]; cti[idx] = a.in[10][((size_t)g * SH + h) * SN + n];
        }
        __syncthreads();
        if (q == 0 && tid < 64) { lam32[(g * 64 + tid) * 2] = pwr[tid * 33 + 32]; lam32[(g * 64 + tid) * 2 + 1] = pwi[tid * 33 + 32]; }
        {
            const int tau = tid >> 4, hb = ((tid >> 2) & 3) * 4, hpb = (tid & 3) * 4;
            float acc[4][4];
#pragma unroll
            for (int i = 0; i < 4; ++i)
#pragma unroll
                for (int j = 0; j < 4; ++j) acc[i][j] = 0.f;
            for (int n = 0; n < 64; ++n) {
                const float pr = pwr[n * 33 + tau], pi = pwi[n * 33 + tau];
                const f32x4 cr = *(const LAS f32x4*)(ctr + n * 16 + hb), ci = *(const LAS f32x4*)(cti + n * 16 + hb);
                const f32x4 br = *(const LAS f32x4*)(bbr + n * 16 + hpb), bi = *(const LAS f32x4*)(bbi + n * 16 + hpb);
                const f32x4 mr = br * pr - bi * pi, mi = br * pi + bi * pr;
#pragma unroll
                for (int i = 0; i < 4; ++i)
#pragma unroll
                    for (int j = 0; j < 4; ++j) acc[i][j] += cr[i] * mr[j] - ci[i] * mi[j];
            }
#pragma unroll
            for (int i = 0; i < 4; ++i) *(LAS f32x4*)(Kt + (tau * 16 + hb + i) * 16 + hpb) = (f32x4){acc[i][0], acc[i][1], acc[i][2], acc[i][3]};
        }
        __syncthreads();
        for (int pz = tid; pz < 128 * 80; pz += NWAVES * 64) {
            const int rl = pz / 80, pc = pz % 80, row = 128 * q + rl, j = row >> 4, h = row & 15;
            float v[8];
            if (pc < 64) {
                const int jp = pc >> 1, hp0 = (pc & 1) * 8;
                if (jp <= j) { const LAS float* kp = Kt + (((j - jp) * 16 + h) * 16 + hp0);
#pragma unroll
                    for (int i = 0; i < 8; ++i) v[i] = kp[i]; }
                else {
#pragma unroll
                    for (int i = 0; i < 8; ++i) v[i] = 0.f; }
            } else {
                const int m0 = (pc - 64) * 8;
#pragma unroll
                for (int i = 0; i < 8; ++i) { const int m = (m0 + i) & 63; const float cr = ctr[m * 16 + h], ci = cti[m * 16 + h], pr = pwr[m * 33 + j + 1], pi = pwi[m * 33 + j + 1];
                    v[i] = (m0 < 64) ? (cr * pr - ci * pi) : -(cr * pi + ci * pr); }
            }
            u32x4 o; o.x = cvt_pk_bf16(v[0], v[1]); o.y = cvt_pk_bf16(v[2], v[3]); o.z = cvt_pk_bf16(v[4], v[5]); o.w = cvt_pk_bf16(v[6], v[7]);
            *(u32x4*)(tz + ((size_t)g * 512 + row) * S5K + pc * 8) = o;
        }
        for (int pz = tid; pz < 64 * 64; pz += NWAVES * 64) {
            const int rl = pz >> 6, pc = pz & 63, row = 64 * q + rl;
            float v[8];
            if (row < 128) {
                const int n = row & 63, jp = pc >> 1, hp0 = (pc & 1) * 8; const float pr = pwr[n * 33 + (LC - 1 - jp)], pi = pwi[n * 33 + (LC - 1 - jp)];
#pragma unroll
                for (int i = 0; i < 8; ++i) { const float br = bbr[n * 16 + hp0 + i], bi = bbi[n * 16 + hp0 + i]; v[i] = (row < 64) ? (pr * br - pi * bi) : (pr * bi + pi * br); }
            } else {
#pragma unroll
                for (int i = 0; i < 8; ++i) v[i] = 0.f; }
            u32x4 o; o.x = cvt_pk_bf16(v[0], v[1]); o.y = cvt_pk_bf16(v[2], v[3]); o.z = cvt_pk_bf16(v[4], v[5]); o.w = cvt_pk_bf16(v[6], v[7]);
            *(u32x4*)(mb + ((size_t)g * 256 + row) * 512 + pc * 8) = o;
        }
    }
    __syncthreads();
}

__device__ __forceinline__ void s5_scan(Frame& F) {
    if (F.wave != 0) return;
    const float* S = (const float*)(F.ws + WS_S); const float* lam32 = (const float*)(F.ws + WS_LAM); bf16_t* s5a = (bf16_t*)(F.ws + WS_S5A);
    for (int g = blockIdx.x; g < SG; g += F.G) {
        const int n = F.lane;
        const float ar = lam32[(g * 64 + n) * 2], ai = lam32[(g * 64 + n) * 2 + 1];
        float sr = 0.f, si = 0.f;
        const float* Sg = S + (size_t)g * NC * 128 + n; bf16_t* xg = s5a + (size_t)g * NC * S5K + LC * SH + n;
#pragma unroll 8
        for (int c = 0; c < NC; ++c) {
            const float pr = Sg[(size_t)c * 128], pi = Sg[(size_t)c * 128 + 64];
            xg[(size_t)c * S5K] = (bf16_t)(cvt_pk_bf16(sr, sr) & 0xffffu); xg[(size_t)c * S5K + 64] = (bf16_t)(cvt_pk_bf16(si, si) & 0xffffu);
            const float nsr = ar * sr - ai * si + pr, nsi = ar * si + ai * sr + pi;
            sr = nsr; si = nsi;
        }
    }
}

__device__ __forceinline__ void conv_phase(Frame& F, const Args& a, int wg0, int nwg) {
    const bf16_t* proj = (const bf16_t*)(F.ws + WS_PROJ); bf16_t* cat = (bf16_t*)(F.ws + WS_CAT);
    const int wgi = (int)blockIdx.x - wg0; if (wgi < 0) return;
    constexpr int TT = 16, NTASK = (T / TT) * 128;
    for (int task = wgi * (NWAVES * 64) + F.tid; task < NTASK; task += nwg * NWAVES * 64) {
        const int c8 = task & 127, t0 = (task >> 7) * TT, c0 = c8 * 8;
        float w[3][8];
#pragma unroll
        for (int k = 0; k < 3; ++k) { const f32x4 w0 = *(const f32x4*)(a.in[3] + k * CW + c0), w1 = *(const f32x4*)(a.in[3] + k * CW + c0 + 4);
#pragma unroll
            for (int i = 0; i < 4; ++i) { w[k][i] = w0[i]; w[k][4 + i] = w1[i]; } }
        float v1[8], v2[8];
#pragma unroll
        for (int i = 0; i < 8; ++i) { v1[i] = 0.f; v2[i] = 0.f; }
        for (int dtt = -2; dtt < TT; ++dtt) {
            const int t = t0 + dtt; if (t < 0) continue;
            const bf16_t* pr = proj + (size_t)t * 3072 + c0;
            const u32x4 gc = *(const u32x4*)(pr + CW), uu = *(const u32x4*)(pr + 2 * CW);
            float v[8];
#pragma unroll
            for (int i = 0; i < 4; ++i) { v[2 * i] = bflo(gc[i]) * bflo(uu[i]); v[2 * i + 1] = bfhi(gc[i]) * bfhi(uu[i]); }
            if (dtt >= 0) {
                const u32x4 gb = *(const u32x4*)pr; float o[8];
#pragma unroll
                for (int i = 0; i < 4; ++i) { o[2 * i] = bflo(gb[i]) * (w[0][2 * i] * v2[2 * i] + w[1][2 * i] * v1[2 * i] + w[2][2 * i] * v[2 * i]);
                                              o[2 * i + 1] = bfhi(gb[i]) * (w[0][2 * i + 1] * v2[2 * i + 1] + w[1][2 * i + 1] * v1[2 * i + 1] + w[2][2 * i + 1] * v[2 * i + 1]); }
                u32x4 ow; ow.x = cvt_pk_bf16(o[0], o[1]); ow.y = cvt_pk_bf16(o[2], o[3]); ow.z = cvt_pk_bf16(o[4], o[5]); ow.w = cvt_pk_bf16(o[6], o[7]);
                *(u32x4*)(cat + (size_t)t * D + c0) = ow;
            }
#pragma unroll
            for (int i = 0; i < 8; ++i) { v2[i] = v1[i]; v1[i] = v[i]; }
        }
    }
}

struct EpiS1 {
    static constexpr bool PERM = false;
    float* S;
    __device__ __forceinline__ void operator()(const f32x4 (&acc)[2][2][4][2], const Unit& u, int wr, int wc, int fr, int fq) const {
#pragma unroll
        for (int ai = 0; ai < 2; ++ai)
#pragma unroll
            for (int m = 0; m < 4; ++m) { const int row = ai * HALF + wr * 64 + m * 16 + fr;
#pragma unroll
                for (int n = 0; n < 2; ++n) *(f32x4*)(S + ((size_t)u.e * NC + row) * 128 + wc * 32 + 16 * n + 4 * fq) = acc[ai][0][m][n]; }
    }
};
struct EpiS3 {
    static constexpr bool PERM = true;
    const bf16_t* s5a; const float* dvec; bf16_t* yg;
    __device__ __forceinline__ void operator()(const f32x4 (&acc)[2][2][4][2], const Unit& u, int wr, int wc, int fr, int fq) const {
        const int g = u.e;
#pragma unroll
        for (int bj = 0; bj < 2; ++bj) {
            const int col = u.pn * BM + bj * HALF + wc * 32 + 8 * fq, h0 = col & 15;
            const f32x4 d0 = *(const f32x4*)(dvec + g * 16 + h0), d1 = *(const f32x4*)(dvec + g * 16 + h0 + 4);
#pragma unroll
            for (int ai = 0; ai < 2; ++ai)
#pragma unroll
                for (int m = 0; m < 4; ++m) { const int row = ai * HALF + wr * 64 + m * 16 + fr;
                    const u32x4 uu = *(const u32x4*)(s5a + ((size_t)g * NC + row) * S5K + col);
                    const f32x4 a0 = acc[ai][bj][m][0], a1 = acc[ai][bj][m][1];
                    float y[8];
                    y[0] = a0[0] + d0[0] * bflo(uu.x); y[1] = a0[1] + d0[1] * bfhi(uu.x); y[2] = a0[2] + d0[2] * bflo(uu.y); y[3] = a0[3] + d0[3] * bfhi(uu.y);
                    y[4] = a1[0] + d1[0] * bflo(uu.z); y[5] = a1[1] + d1[1] * bfhi(uu.z); y[6] = a1[2] + d1[2] * bflo(uu.w); y[7] = a1[3] + d1[3] * bfhi(uu.w);
#pragma unroll
                    for (int i = 0; i < 8; ++i) y[i] = gelu_tanh_f(y[i]);
                    u32x4 w; w.x = cvt_pk_bf16(y[0], y[1]); w.y = cvt_pk_bf16(y[2], y[3]); w.z = cvt_pk_bf16(y[4], y[5]); w.w = cvt_pk_bf16(y[6], y[7]);
                    *(u32x4*)(yg + ((size_t)g * NC + row) * 512 + col) = w; }
        }
    }
};
struct EpiG2 {
    static constexpr bool PERM = true;
    const bf16_t* yg; const float* bias; bf16_t* cat;
    __device__ __forceinline__ void operator()(const f32x4 (&acc)[2][2][4][2], const Unit& u, int wr, int wc, int fr, int fq) const {
#pragma unroll
        for (int bj = 0; bj < 2; ++bj) {
            const int col = u.pn * BM + bj * HALF + wc * 32 + 8 * fq;
            const f32x4 b0 = *(const f32x4*)(bias + col), b1 = *(const f32x4*)(bias + col + 4);
#pragma unroll
            for (int ai = 0; ai < 2; ++ai)
#pragma unroll
                for (int m = 0; m < 4; ++m) { const int t = u.pm * BM + ai * HALF + wr * 64 + m * 16 + fr;
                    const u32x4 yy = *(const u32x4*)(yg + ((size_t)(col >> 4) * T + t) * 16 + (col & 15));
                    const f32x4 z0 = acc[ai][bj][m][0] + b0, z1 = acc[ai][bj][m][1] + b1;
                    float o[8];
                    o[0] = bflo(yy.x) * sigmoid_f(z0[0]); o[1] = bfhi(yy.x) * sigmoid_f(z0[1]); o[2] = bflo(yy.y) * sigmoid_f(z0[2]); o[3] = bfhi(yy.y) * sigmoid_f(z0[3]);
                    o[4] = bflo(yy.z) * sigmoid_f(z1[0]); o[5] = bfhi(yy.z) * sigmoid_f(z1[1]); o[6] = bflo(yy.w) * sigmoid_f(z1[2]); o[7] = bfhi(yy.w) * sigmoid_f(z1[3]);
                    u32x4 w; w.x = cvt_pk_bf16(o[0], o[1]); w.y = cvt_pk_bf16(o[2], o[3]); w.z = cvt_pk_bf16(o[4], o[5]); w.w = cvt_pk_bf16(o[6], o[7]);
                    *(u32x4*)(cat + (size_t)t * D + CW + col) = w; }
        }
    }
};
struct EpiRes {
    static constexpr bool PERM = false;
    const float* xi; float* xo; bf16_t* xb;
    __device__ __forceinline__ void operator()(const f32x4 (&acc)[2][2][4][2], const Unit& u, int wr, int wc, int fr, int fq) const {
#pragma unroll
        for (int ai = 0; ai < 2; ++ai)
#pragma unroll
            for (int m = 0; m < 4; ++m) { const size_t row = (size_t)(u.pm * BM + ai * HALF + wr * 64 + m * 16 + fr);
#pragma unroll
                for (int bj = 0; bj < 2; ++bj)
#pragma unroll
                    for (int n = 0; n < 2; ++n) { const int col = u.pn * BM + bj * HALF + wc * 32 + 16 * n + 4 * fq;
                        const f32x4 v = *(const f32x4*)(xi + row * D + col) + acc[ai][bj][m][n];
                        *(f32x4*)(xo + row * D + col) = v;
                        u32x2 w; w.x = cvt_pk_bf16(v[0], v[1]); w.y = cvt_pk_bf16(v[2], v[3]); *(u32x2*)(xb + row * D + col) = w; } }
    }
};


__device__ __forceinline__ void p0_small(Frame& F, const Args& a) {
    bf16_t* wr = (bf16_t*)(F.ws + WS_WR); float* wf = (float*)(F.ws + WS_WF);
    const int gt = (int)blockIdx.x * (NWAVES * 64) + F.tid, NGT = F.G * NWAVES * 64;
    for (int idx = gt; idx < 2 * 48 * D; idx += NGT) {
        const int layer = idx / (48 * D), rem = idx % (48 * D), n = rem / D, k = rem % D;
        float v = 0.f;
        if (n < 4) v = a.in[20][((size_t)layer * D + k) * 4 + n];
        else if (n < 36) v = a.in[22][((size_t)layer * D + k) * 32 + (n - 4)];
        v *= a.in[19][(size_t)layer * D + k];
        const unsigned hi = cvt_pk_bf16(v, v) & 0xffffu; const float lo = v - bf2f((unsigned short)hi);
        wr[((size_t)(layer * 2 + 0) * 48 + n) * D + k] = (bf16_t)hi;
        wr[((size_t)(layer * 2 + 1) * 48 + n) * D + k] = (bf16_t)(cvt_pk_bf16(lo, lo) & 0xffffu);
    }
    for (int idx = gt; idx < NH * D; idx += NGT) { const int h = idx / D, k = idx % D; wf[idx] = a.in[16][(size_t)k * (3 * D + NH) + 3 * D + h] * a.in[15][k]; }
}

__device__ __forceinline__ void router_phase(Frame& F, const Args& a, int layer) {
    const float* X = (const float*)(F.ws + WS_XA); float* rr = (float*)(F.ws + WS_R);
    const bf16_t* wr = (const bf16_t*)(F.ws + WS_WR) + (size_t)layer * 2 * 48 * D;
    int* cnt = (int*)(F.ctl + CW_CNT) + layer * 64; int* list = (int*)(F.ws + WS_LIST); float* pw = (float*)(F.ws + WS_PW);
    LAS float* P = (LAS float*)F.lds;
    LAS float* SS = P + 2 * 4 * 16 * 48;
    const int rt = F.wave >> 2, kq = F.wave & 3, li = F.lane & 15, kg = F.lane >> 4;
    for (int item = blockIdx.x; item < T / 32; item += F.G) {
        const int r0 = item * 32 + rt * 16;
        f32x4 acc[3]; acc[0] = acc[1] = acc[2] = (f32x4){0.f, 0.f, 0.f, 0.f};
        float ss = 0.f;
        const float* xp = X + (size_t)(r0 + li) * D + kq * 512 + 8 * kg;
        const bf16_t* wp = wr + (size_t)li * D + kq * 512 + 8 * kg;
#pragma unroll 2
        for (int ks = 0; ks < 16; ++ks) {
            const f32x4 x0 = *(const f32x4*)(xp + ks * 32), x1 = *(const f32x4*)(xp + ks * 32 + 4);
            ss += (x0[0] * x0[0] + x0[1] * x0[1]) + (x0[2] * x0[2] + x0[3] * x0[3]) + (x1[0] * x1[0] + x1[1] * x1[1]) + (x1[2] * x1[2] + x1[3] * x1[3]);
            u32x4 hw; hw.x = cvt_pk_bf16(x0[0], x0[1]); hw.y = cvt_pk_bf16(x0[2], x0[3]); hw.z = cvt_pk_bf16(x1[0], x1[1]); hw.w = cvt_pk_bf16(x1[2], x1[3]);
            u32x4 lw; lw.x = cvt_pk_bf16(x0[0] - bflo(hw.x), x0[1] - bfhi(hw.x)); lw.y = cvt_pk_bf16(x0[2] - bflo(hw.y), x0[3] - bfhi(hw.y));
            lw.z = cvt_pk_bf16(x1[0] - bflo(hw.z), x1[1] - bfhi(hw.z)); lw.w = cvt_pk_bf16(x1[2] - bflo(hw.w), x1[3] - bfhi(hw.w));
            const bf16x8 ah = __builtin_bit_cast(bf16x8, hw), al = __builtin_bit_cast(bf16x8, lw);
#pragma unroll
            for (int ct = 0; ct < 3; ++ct) {
                const bf16x8 bh = *(const bf16x8*)(wp + (size_t)ct * 16 * D + ks * 32);
                const bf16x8 bl = *(const bf16x8*)(wp + (size_t)(48 + ct * 16) * D + ks * 32);
                acc[ct] = __builtin_amdgcn_mfma_f32_16x16x32_bf16(ah, bh, acc[ct], 0, 0, 0);
                acc[ct] = __builtin_amdgcn_mfma_f32_16x16x32_bf16(al, bh, acc[ct], 0, 0, 0);
                acc[ct] = __builtin_amdgcn_mfma_f32_16x16x32_bf16(ah, bl, acc[ct], 0, 0, 0);
            }
        }
        ss += __shfl_xor(ss, 16); ss += __shfl_xor(ss, 32);
        __syncthreads();
#pragma unroll
        for (int ct = 0; ct < 3; ++ct)
#pragma unroll
            for (int rg = 0; rg < 4; ++rg) P[((rt * 4 + kq) * 16 + 4 * kg + rg) * 48 + ct * 16 + li] = acc[ct][rg];
        if (kg == 0) SS[(rt * 4 + kq) * 16 + li] = ss;
        __syncthreads();
        if (kq == 0 && F.lane < 16) {
            const int row = F.lane, t = r0 + row;
            float lg[36];
#pragma unroll
            for (int c = 0; c < 36; ++c) lg[c] = (P[((rt * 4 + 0) * 16 + row) * 48 + c] + P[((rt * 4 + 1) * 16 + row) * 48 + c]) + (P[((rt * 4 + 2) * 16 + row) * 48 + c] + P[((rt * 4 + 3) * 16 + row) * 48 + c]);
            const float sq = (SS[(rt * 4 + 0) * 16 + row] + SS[(rt * 4 + 1) * 16 + row]) + (SS[(rt * 4 + 2) * 16 + row] + SS[(rt * 4 + 3) * 16 + row]);
            const float r = rsqrtf(sq * (1.f / D) + EPS);
            rr[t] = r;
            float g4[4];
#pragma unroll
            for (int i = 0; i < 4; ++i) g4[i] = lg[i] * r + a.in[21][layer * 4 + i];
            float gmax = g4[0]; int gi = 0;
#pragma unroll
            for (int i = 1; i < 4; ++i) if (g4[i] > gmax) { gmax = g4[i]; gi = i; }
            float den = 0.f;
#pragma unroll
            for (int i = 0; i < 4; ++i) den += __expf(g4[i] - gmax);
            const float gw = 1.f / den;
            float e8[8];
#pragma unroll
            for (int i = 0; i < 8; ++i) {
                const float v0 = lg[4 + i], v1 = lg[12 + i], v2 = lg[20 + i], v3 = lg[28 + i];
                const float v = gi == 0 ? v0 : (gi == 1 ? v1 : (gi == 2 ? v2 : v3));
                e8[i] = v * r + a.in[23][layer * 32 + gi * 8 + i];
            }
            float v1 = e8[0]; int e1 = 0;
#pragma unroll
            for (int i = 1; i < 8; ++i) if (e8[i] > v1) { v1 = e8[i]; e1 = i; }
            float v2 = -3.0e38f; int e2 = 0;
#pragma unroll
            for (int i = 0; i < 8; ++i) if (i != e1 && e8[i] > v2) { v2 = e8[i]; e2 = i; }
            const float w1 = 1.f / (1.f + __expf(v2 - v1)), w2 = 1.f - w1;
            const int E1 = gi * 8 + e1, E2 = gi * 8 + e2;
            const int p1 = atomicAdd(&cnt[E1], 1); list[E1 * T + p1] = 2 * t;
            const int p2 = atomicAdd(&cnt[E2], 1); list[E2 * T + p2] = 2 * t + 1;
            pw[2 * t] = w1 * gw; pw[2 * t + 1] = w2 * gw;
        }
    }
    __syncthreads();
}

struct MoeOrder {
    const LAS int* tab; const int* list; const char* Abase; const char* Bbase; size_t bexp, bstep, arow2; int nN, G, c; bool gather;
    __device__ __forceinline__ bool next(int i, Unit& u) const {
        const int L = i * G + c; if (L >= __builtin_amdgcn_readfirstlane(tab[32])) return false;
        int E = 0;
        for (int j = 1; j < 32; ++j) E += (__builtin_amdgcn_readfirstlane(tab[j]) <= L) ? 1 : 0;
        const int local = L - __builtin_amdgcn_readfirstlane(tab[E]), mt = local / nN, pn = local % nN, hb = __builtin_amdgcn_readfirstlane(tab[33 + E]), cn = __builtin_amdgcn_readfirstlane(tab[34 + E]) - hb;
        u.e = E; u.pm = mt; u.pn = pn; u.nvalid = (cn - mt * BM) < BM ? (cn - mt * BM) : BM; u.rows = list + (size_t)E * T + mt * BM; u.aux = hb + mt * BM;
        u.A = gather ? Abase : Abase + (size_t)u.aux * arow2; u.B = Bbase + (size_t)E * bexp + (size_t)pn * bstep; return true;
    }
};
__device__ __forceinline__ void moe_tables(Frame& F, int layer, int nN) {
    LAS int* tab = (LAS int*)(F.lds + LDSCTL_OFF);
    __syncthreads();
    if (F.tid == 0) {
        const int* cnt = (const int*)(F.ctl + CW_CNT) + layer * 64;
        int up = 0, rp = 0;
        for (int e = 0; e < 32; ++e) { const int c = __hip_atomic_load(cnt + e, __ATOMIC_RELAXED, __HIP_MEMORY_SCOPE_AGENT); tab[e] = up; tab[33 + e] = rp; up += ((c + BM - 1) / BM) * nN; rp += c; }
        tab[32] = up; tab[65] = rp;
    }
    __syncthreads();
}
struct EpiM1 {
    static constexpr bool PERM = true;
    const float* rr; bf16_t* H;
    __device__ __forceinline__ void operator()(const f32x4 (&acc)[2][2][4][2], const Unit& u, int wr, int wc, int fr, int fq) const {
        const int col = u.pn * 128 + wc * 32 + 8 * fq;
#pragma unroll
        for (int ai = 0; ai < 2; ++ai)
#pragma unroll
            for (int m = 0; m < 4; ++m) { const int lr = ai * HALF + wr * 64 + m * 16 + fr;
                if (lr < u.nvalid) {
                    const float sc = rr[u.rows[lr] >> 1];
                    float o[8];
#pragma unroll
                    for (int n = 0; n < 2; ++n)
#pragma unroll
                        for (int i = 0; i < 4; ++i) { const float g = acc[ai][0][m][n][i] * sc, up = acc[ai][1][m][n][i] * sc; o[4 * n + i] = g * sigmoid_f(g) * up; }
                    u32x4 w; w.x = cvt_pk_bf16(o[0], o[1]); w.y = cvt_pk_bf16(o[2], o[3]); w.z = cvt_pk_bf16(o[4], o[5]); w.w = cvt_pk_bf16(o[6], o[7]);
                    *(u32x4*)(H + (size_t)(u.aux + lr) * FF + col) = w; } }
    }
};
struct EpiM2 {
    static constexpr bool PERM = true;
    const float* pw; bf16_t* Y;
    __device__ __forceinline__ void operator()(const f32x4 (&acc)[2][2][4][2], const Unit& u, int wr, int wc, int fr, int fq) const {
#pragma unroll
        for (int ai = 0; ai < 2; ++ai)
#pragma unroll
            for (int m = 0; m < 4; ++m) { const int lr = ai * HALF + wr * 64 + m * 16 + fr;
                if (lr < u.nvalid) {
                    const int p = u.rows[lr]; const float w8 = pw[p];
#pragma unroll
                    for (int bj = 0; bj < 2; ++bj) { const f32x4 v0 = acc[ai][bj][m][0] * w8, v1 = acc[ai][bj][m][1] * w8;
                        u32x4 w; w.x = cvt_pk_bf16(v0[0], v0[1]); w.y = cvt_pk_bf16(v0[2], v0[3]); w.z = cvt_pk_bf16(v1[0], v1[1]); w.w = cvt_pk_bf16(v1[2], v1[3]);
                        *(u32x4*)(Y + (size_t)p * D + u.pn * BM + bj * HALF + wc * 32 + 8 * fq) = w; } } }
    }
};
__device__ __forceinline__ void moe_gemms_m1(Frame& F, int layer) {
    moe_tables(F, layer, 4);
    MoeOrder S; S.tab = (const LAS int*)(F.lds + LDSCTL_OFF); S.list = (const int*)(F.ws + WS_LIST); S.Abase = (const char*)(F.ws + WS_XB);
    S.Bbase = (const char*)(F.ws + WS_WGU) + (size_t)layer * NE * 1024 * D * 2; S.bexp = (size_t)1024 * D * 2; S.bstep = (size_t)BM * D * 2; S.arow2 = 0; S.nN = 4; S.G = F.G; S.c = (int)blockIdx.x; S.gather = true;
    EpiM1 E{(const float*)(F.ws + WS_R), (bf16_t*)(F.ws + WS_H)};
    gemm_phase<AGather, EpiM1, MoeOrder, false, true>(F.lds, D, AGather{D * 2}, S, E);
}
__device__ __forceinline__ void moe_gemms_m2(Frame& F, int layer) {
    moe_tables(F, layer, 8);
    MoeOrder S; S.tab = (const LAS int*)(F.lds + LDSCTL_OFF); S.list = (const int*)(F.ws + WS_LIST); S.Abase = (const char*)(F.ws + WS_H);
    S.Bbase = (const char*)(F.ws + WS_WD) + (size_t)layer * NE * D * FF * 2; S.bexp = (size_t)D * FF * 2; S.bstep = (size_t)BM * FF * 2; S.arow2 = (size_t)FF * 2; S.nN = 8; S.G = F.G; S.c = (int)blockIdx.x; S.gather = false;
    EpiM2 E{(const float*)(F.ws + WS_PW), (bf16_t*)(F.ws + WS_Y)};
    gemm_phase<ARow, EpiM2, MoeOrder, false, true>(F.lds, FF, ARow{FF * 2}, S, E);
}

template <int MODE>
__device__ __forceinline__ void combine_phase(Frame& F, const Args& a) {
    const float* X = (const float*)(F.ws + WS_XA); const bf16_t* Y = (const bf16_t*)(F.ws + WS_Y);
    const int gw = F.vcu * NWAVES + F.wave, NGW = F.G * NWAVES;
    LAS float* wfl = (LAS float*)F.lds;
    if (MODE == 0) {
        const float* wf = (const float*)(F.ws + WS_WF);
        for (int i = F.tid; i < NH * D / 4; i += NWAVES * 64) *(LAS f32x4*)(wfl + 4 * i) = *(const f32x4*)(wf + 4 * i);
        __syncthreads();
    }
    for (int t = gw; t < T; t += NGW) {
        const f32x4* xr = (const f32x4*)(X + (size_t)t * D) + F.lane;
        const u32x2* y0 = (const u32x2*)(Y + (size_t)(2 * t) * D) + F.lane; const u32x2* y1 = (const u32x2*)(Y + (size_t)(2 * t + 1) * D) + F.lane;
        f32x4 v[8]; float s = 0.f;
#pragma unroll
        for (int j = 0; j < 8; ++j) { const f32x4 x = xr[64 * j]; const u32x2 p = y0[64 * j], q = y1[64 * j];
            v[j][0] = x[0] + (bflo(p.x) + bflo(q.x)); v[j][1] = x[1] + (bfhi(p.x) + bfhi(q.x)); v[j][2] = x[2] + (bflo(p.y) + bflo(q.y)); v[j][3] = x[3] + (bfhi(p.y) + bfhi(q.y));
            s += (v[j][0] * v[j][0] + v[j][1] * v[j][1]) + (v[j][2] * v[j][2] + v[j][3] * v[j][3]); }
        s = wave_sum(s);
        const float r = rsqrtf(s * (1.f / D) + EPS);
        if (MODE == 0) {
            f32x4* xo = (f32x4*)((float*)(F.ws + WS_XBB) + (size_t)t * D) + F.lane; u32x2* xb = (u32x2*)((bf16_t*)(F.ws + WS_XB) + (size_t)t * D) + F.lane;
#pragma unroll
            for (int j = 0; j < 8; ++j) { xo[64 * j] = v[j]; u32x2 w; w.x = cvt_pk_bf16(v[j][0], v[j][1]); w.y = cvt_pk_bf16(v[j][2], v[j][3]); xb[64 * j] = w; }
            if (F.lane == 0) ((float*)(F.ws + WS_R))[t] = r;
            float myf = 0.f;
#pragma unroll
            for (int h = 0; h < NH; ++h) {
                float d = 0.f;
#pragma unroll
                for (int j = 0; j < 8; ++j) { const f32x4 w = *(const LAS f32x4*)(wfl + h * D + 256 * j + 4 * F.lane); d += (v[j][0] * w[0] + v[j][1] * w[1]) + (v[j][2] * w[2] + v[j][3] * w[3]); }
                d = wave_sum(d);
                if (F.lane == h) myf = d;
            }
            if (F.lane < NH) { const float z = myf * r + a.in[17][F.lane]; ((float*)(F.ws + WS_LOGF))[(size_t)t * NH + F.lane] = fminf(z, 0.f) - log1pf(__expf(-fabsf(z))); }
        } else {
            const f32x4* gp = (const f32x4*)a.in[27] + F.lane; f32x4* op = (f32x4*)(a.out + (size_t)t * D) + F.lane;
#pragma unroll
            for (int j = 0; j < 8; ++j) { const f32x4 g = gp[64 * j]; op[64 * j] = v[j] * r * g; }
        }
    }
    if (MODE == 0) __syncthreads();
}


namespace att {
constexpr int AD = 128;
constexpr float SCALE = 0.08838834764831845f;
constexpr float THR = 8.f;
constexpr int NW = 8, QBLK = 32, KVBLK = 64, QB = NW * QBLK;
constexpr int SHM_V = KVBLK * AD * 2, SHM_K = KVBLK * AD * 2;
constexpr int CK_OFF = 2 * SHM_V + 2 * SHM_K + NW * 64 * 4;
constexpr int OST = 2048;
#define KSWZ(row, colB) ((row) * 256 + ((colB) ^ (((row) & 7) << 4)))
#define SBAR() __builtin_amdgcn_sched_barrier(0)
__device__ __forceinline__ int v_st(int k, int c) { const int kk = (k & ~0xC) | ((k & 4) << 1) | ((k & 8) >> 1); return ((kk >> 3) * 4 + (c >> 5)) * 512 + ((kk & 7) * 32 + (c & 31)) * 2; }
__device__ __forceinline__ int v_rd_base(int lane) { return ((lane & 3) << 3) | (((lane >> 2) & 3) << 6) | (((lane >> 4) & 1) << 5) | (((lane >> 5) & 1) << 8); }
constexpr int v_rd_off(int d0, int ks, int half) { return d0 * 512 + ks * 4096 + half * 2048; }
__device__ __forceinline__ int crow(int r, int hi) { return (r & 3) + 8 * (r >> 2) + 4 * hi; }
__device__ __forceinline__ unsigned cvtpk(float lo, float hi) { unsigned r; asm volatile("v_cvt_pk_bf16_f32 %0, %1, %2" : "=v"(r) : "v"(lo), "v"(hi)); return r; }
__device__ __forceinline__ bf16x8 load8(const bf16_t* p) { return *reinterpret_cast<const bf16x8*>(p); }
__device__ __forceinline__ void mask_tile(f32x16& p0, f32x16& p1, int dq) {
    const float NEG = -__builtin_inff();
#pragma unroll
    for (int r = 0; r < 16; ++r) {
        const int c = (r & 3) + 8 * (r >> 2);
        if (dq - c < 0) p0[r] = NEG;
        if (dq - c - 32 < 0) p1[r] = NEG;
    }
}
__device__ __forceinline__ void partialSM(f32x16& p0, f32x16& p1, float& m_reg, float& mn, float& alpha) {
    float pmax = p0[0];
#pragma unroll
    for (int r = 1; r < 16; ++r) pmax = fmaxf(pmax, p0[r]);
#pragma unroll
    for (int r = 0; r < 16; ++r) pmax = fmaxf(pmax, p1[r]);
    { auto rr = __builtin_amdgcn_permlane32_swap(__float_as_uint(pmax), __float_as_uint(pmax), false, false);
      pmax = fmaxf(__uint_as_float(rr[0]), __uint_as_float(rr[1])); }
    constexpr float C2 = 1.4426950408889634f * SCALE;
    if (__builtin_expect(__all((pmax - m_reg) * SCALE <= THR), 1)) { mn = m_reg; alpha = 1.f; }
    else { mn = fmaxf(m_reg, pmax); alpha = __builtin_amdgcn_exp2f((m_reg - mn) * C2); m_reg = mn; }
    const float mnL = -mn * C2;
#pragma unroll
    for (int r = 0; r < 16; ++r) p0[r] = fmaf(p0[r], C2, mnL);
#pragma unroll
    for (int r = 0; r < 16; ++r) p1[r] = fmaf(p1[r], C2, mnL);
#pragma unroll
    for (int r = 0; r < 16; ++r) p0[r] = __builtin_amdgcn_exp2f(p0[r]);
}
__device__ __forceinline__ void finishSM(f32x16& p0, f32x16& p1, float alpha, float& l_reg, bf16x8& pa0, bf16x8& pa1, bf16x8& pa2, bf16x8& pa3) {
#pragma unroll
    for (int r = 0; r < 16; ++r) p1[r] = __builtin_amdgcn_exp2f(p1[r]);
    float ps = 0;
#pragma unroll
    for (int r = 0; r < 16; ++r) ps += p0[r];
#pragma unroll
    for (int r = 0; r < 16; ++r) ps += p1[r];
    { auto rr = __builtin_amdgcn_permlane32_swap(__float_as_uint(ps), __float_as_uint(ps), false, false);
      ps = __uint_as_float(rr[0]) + __uint_as_float(rr[1]); }
    l_reg = l_reg * alpha + ps;
#define PK4(P, B_, OUT) do { unsigned a0 = cvtpk(P[B_+0], P[B_+1]), a1 = cvtpk(P[B_+2], P[B_+3]);                          \
        unsigned b0 = cvtpk(P[B_+4], P[B_+5]), b1 = cvtpk(P[B_+6], P[B_+7]);                                             \
        auto r0 = __builtin_amdgcn_permlane32_swap(a0, b0, false, false); auto r1 = __builtin_amdgcn_permlane32_swap(a1, b1, false, false); \
        u32x4 w = {r0[0], r1[0], r0[1], r1[1]}; OUT = *reinterpret_cast<bf16x8*>(&w); } while (0)
    PK4(p0, 0, pa0); PK4(p0, 8, pa1); PK4(p1, 0, pa2); PK4(p1, 8, pa3);
#undef PK4
}
template <int KB>
__device__ __forceinline__ void qkt(f32x16& p0, f32x16& p1, const char* K_lds, int r32, int hi, const bf16x8* qr, const float* ckt, float cq) {
#pragma unroll
    for (int q = 0; q < 4; ++q) {
        const f32x4 c0 = *(const f32x4*)(ckt + 8 * q + 4 * hi), c1 = *(const f32x4*)(ckt + 32 + 8 * q + 4 * hi);
#pragma unroll
        for (int i = 0; i < 4; ++i) { p0[4 * q + i] = cq - c0[i]; p1[4 * q + i] = cq - c1[i]; }
    }
    const char* kb[4];
#pragma unroll
    for (int dd = 0; dd < 4; ++dd) kb[dd] = K_lds + KB * SHM_K + KSWZ(r32, (dd * 16 + hi * 8) * 2);
#pragma unroll
    for (int d0 = 0; d0 < 8; ++d0) { const char* a = kb[d0 & 3] + (d0 >> 2) * 128;
        bf16x8 b0 = *reinterpret_cast<const bf16x8*>(a);
        bf16x8 b1 = *reinterpret_cast<const bf16x8*>(a + 32 * 256);
        p0 = __builtin_amdgcn_mfma_f32_32x32x16_bf16(b0, qr[d0], p0, 0, 0, 0);
        p1 = __builtin_amdgcn_mfma_f32_32x32x16_bf16(b1, qr[d0], p1, 0, 0, 0); }
}
template <int VB>
__device__ __forceinline__ void pv_tile(f32x16* o, int vb0, bf16x8 pa0, bf16x8 pa1, bf16x8 pa2, bf16x8 pa3) {
#define TRRD(dst, off) asm volatile("ds_read_b64_tr_b16 %0, %1 offset:%2" : "=&v"(dst) : "v"(vb0), "i"(off) : "memory")
#define PV_D0(d0) do { s16x4 l0, l1, l2, l3, h0, h1, h2, h3; constexpr int b_ = VB * SHM_V + v_rd_off(d0, 0, 0); \
        TRRD(l0, b_); TRRD(h0, b_ + 2048); TRRD(l1, b_ + 4096); TRRD(h1, b_ + 6144); TRRD(l2, b_ + 8192); TRRD(h2, b_ + 10240); TRRD(l3, b_ + 12288); TRRD(h3, b_ + 14336); \
        asm volatile("s_waitcnt lgkmcnt(0)" ::: "memory"); SBAR();   \
        o[d0] = __builtin_amdgcn_mfma_f32_32x32x16_bf16(pa0, (bf16x8){l0[0], l0[1], l0[2], l0[3], h0[0], h0[1], h0[2], h0[3]}, o[d0], 0, 0, 0);   \
        o[d0] = __builtin_amdgcn_mfma_f32_32x32x16_bf16(pa1, (bf16x8){l1[0], l1[1], l1[2], l1[3], h1[0], h1[1], h1[2], h1[3]}, o[d0], 0, 0, 0);   \
        o[d0] = __builtin_amdgcn_mfma_f32_32x32x16_bf16(pa2, (bf16x8){l2[0], l2[1], l2[2], l2[3], h2[0], h2[1], h2[2], h2[3]}, o[d0], 0, 0, 0);   \
        o[d0] = __builtin_amdgcn_mfma_f32_32x32x16_bf16(pa3, (bf16x8){l3[0], l3[1], l3[2], l3[3], h3[0], h3[1], h3[2], h3[3]}, o[d0], 0, 0, 0); } while (0)
    PV_D0(0); PV_D0(1); PV_D0(2); PV_D0(3);
#undef PV_D0
#undef TRRD
}
struct BlockRef { const bf16_t* Q; const bf16_t* K; const bf16_t* V; bf16_t* O; const float* ck; int P0; };
struct Seam { bf16x8 qr[8]; bf16x8 st_v0, st_v1, st_k0, st_k1; };
#define ROW(p, k0, rr) ((p) + (size_t)((k0) + (rr)) * AD + sc)
#define VMW() asm volatile("s_waitcnt vmcnt(0)" ::: "memory")
#define VMWN(n) asm volatile("s_waitcnt vmcnt(%0)" :: "i"(n) : "memory")
#define SLOAD_H(Kp, Vp, k0) do { S.st_v0 = load8(ROW(Vp, k0, sr)); S.st_v1 = load8(ROW(Vp, k0, 32 + sr));              \
                         S.st_k0 = load8(ROW(Kp, k0, sr)); S.st_k1 = load8(ROW(Kp, k0, 32 + sr)); } while (0)
#define SWRITE_HK(bf) do { *(bf16x8*)(K_lds + (bf) * SHM_K + kws) = S.st_k0; *(bf16x8*)(K_lds + (bf) * SHM_K + kws + 32 * 256) = S.st_k1; } while (0)
#define SWRITE_HV(bf) do { *(bf16x8*)(V_lds + (bf) * SHM_V + vst0) = S.st_v0; *(bf16x8*)(V_lds + (bf) * SHM_V + vst1) = S.st_v1; } while (0)
#define SWRITE_H(bf) do { SWRITE_HV(bf); SWRITE_HK(bf); } while (0)
__device__ __forceinline__ void fox_prime(const BlockRef& cur, char* lds, Seam& S) {
    int tid = threadIdx.x; asm volatile("" : "+v"(tid));
    const int wid = __builtin_amdgcn_readfirstlane(tid >> 6), lane = tid & 63, r32 = lane & 31, hi = lane >> 5;
    const int sr = tid >> 4, sc = (tid & 15) * 8, kws = KSWZ(sr, sc * 2); char* K_lds = lds + 2 * SHM_V;
#pragma unroll
    for (int d0 = 0; d0 < 8; ++d0) S.qr[d0] = load8(cur.Q + (size_t)(wid * QBLK + r32) * AD + d0 * 16 + hi * 8);
    SLOAD_H(cur.K, cur.V, 0); VMW(); SWRITE_HK(0);
    __syncthreads();
}
__device__ __forceinline__ void fox_block(const BlockRef& cur, const BlockRef& nxt, char* lds, Seam& S) {
    int tid = threadIdx.x; asm volatile("" : "+v"(tid));
    const int wid = __builtin_amdgcn_readfirstlane(tid >> 6), lane = tid & 63, r32 = lane & 31, hi = lane >> 5;
    const int NT = (cur.P0 + QB - 1) / KVBLK + 1;
    const int qlo = cur.P0 + wid * QBLK, qm = qlo + r32 - 4 * hi;
    char* V_lds = lds; char* K_lds = lds + 2 * SHM_V;
    float* ws = (float*)(lds + 2 * SHM_V + 2 * SHM_K) + wid * 64; float* li_l = ws, * al_l = ws + 32;
    float* ckl = (float*)(lds + CK_OFF);
    { const int nq = (cur.P0 + QB) >> 2; for (int i = tid; i < nq; i += NW * 64) *(f32x4*)(ckl + 4 * i) = *(const f32x4*)(cur.ck + 4 * i); }
    __syncthreads();
    const float cq = ckl[qlo + r32];
    float m_reg = -1e30f, l_reg = 0; f32x16 o[4] = {};
    const int sr = tid >> 4, sc = (tid & 15) * 8, vst0 = v_st(sr, sc), vst1 = v_st(32 + sr, sc), kws = KSWZ(sr, sc * 2);
    const int vb0 = (int)(uintptr_t)V_lds + v_rd_base(lane);
    const bf16_t* Kh = cur.K; const bf16_t* Vh = cur.V;
#define RESC(a) do { if (__any((a) < 1.f)) { if (hi == 0) al_l[r32] = (a); asm volatile("s_waitcnt lgkmcnt(0)" ::: "memory");              \
                     for (int d_ = 0; d_ < 4; ++d_) for (int r = 0; r < 16; ++r) o[d_][r] *= al_l[crow(r, hi)]; } } while (0)
#define KBASE(t) ((t) * KVBLK)
#define MASKT(P0_, P1_, t) do { const int kb_ = KBASE(t); if (kb_ + KVBLK - 1 > qlo) mask_tile(P0_, P1_, qm - kb_); } while (0)
    constexpr int NQL = 8;
#define SEAM_K0() do { VMWN(NQL); SWRITE_HK(0); SBAR(); } while (0)
    f32x16 pA0, pA1, pB0, pB1; float mnA, mnB, alA, alB; bf16x8 pa0, pa1, pa2, pa3;
    SWRITE_HV(0); SBAR();
    if (NT > 1) { SLOAD_H(Kh, Vh, KBASE(1)); }
    SBAR(); qkt<0>(pA0, pA1, K_lds, r32, hi, S.qr, ckl + KBASE(0), cq);
    MASKT(pA0, pA1, 0); partialSM(pA0, pA1, m_reg, mnA, alA);
    if (NT > 1) { VMW(); SWRITE_H(1); }
    __syncthreads();
#define HALF_STEP(PX0, PX1, mnX, alX, PY0, PY1, alY, t, KB, VB, SB) do {                                                      \
        SBAR(); qkt<KB>(PX0, PX1, K_lds, r32, hi, S.qr, ckl + KBASE(t), cq);                                                   \
        finishSM(PY0, PY1, alY, l_reg, pa0, pa1, pa2, pa3); SBAR();                                                           \
        if ((t) + 1 < NT) { SLOAD_H(Kh, Vh, KBASE((t) + 1)); SBAR(); }                                                        \
        pv_tile<VB>(o, vb0, pa0, pa1, pa2, pa3); MASKT(PX0, PX1, (t)); partialSM(PX0, PX1, m_reg, mnX, alX);                   \
        __syncthreads();                                                                                                      \
        if ((t) + 1 < NT) { VMW(); SWRITE_H(SB); }                                                                            \
        RESC(alX); __syncthreads(); } while (0)
    for (int t = 1; t + 1 < NT; t += 2) {
        HALF_STEP(pB0, pB1, mnB, alB, pA0, pA1, alA, t, 1, 0, 0);
        HALF_STEP(pA0, pA1, mnA, alA, pB0, pB1, alB, t + 1, 0, 1, 1);
    }
    const bool even = (NT & 1) == 0;
    if (even) { SBAR(); qkt<1>(pB0, pB1, K_lds, r32, hi, S.qr, ckl + KBASE(NT - 1), cq); SBAR(); }
    SLOAD_H(nxt.K, nxt.V, 0); SBAR();
#pragma unroll
    for (int d0 = 0; d0 < 8; ++d0) S.qr[d0] = load8(nxt.Q + (size_t)(wid * QBLK + r32) * AD + d0 * 16 + hi * 8);
    SBAR();
    finishSM(pA0, pA1, alA, l_reg, pa0, pa1, pa2, pa3); SBAR();
    pv_tile<0>(o, vb0, pa0, pa1, pa2, pa3);
    if (even) { MASKT(pB0, pB1, NT - 1); partialSM(pB0, pB1, m_reg, mnB, alB); __syncthreads(); RESC(alB);
        finishSM(pB0, pB1, alB, l_reg, pa0, pa1, pa2, pa3); SBAR(); pv_tile<1>(o, vb0, pa0, pa1, pa2, pa3); }
    SBAR(); SEAM_K0();
    if (hi == 0) li_l[r32] = l_reg; asm volatile("s_waitcnt lgkmcnt(0)" ::: "memory");
    float rli[16];
#pragma unroll
    for (int r = 0; r < 16; ++r) rli[r] = __builtin_amdgcn_rcpf(li_l[crow(r, hi)]);
    bf16_t* Ow = cur.O + (size_t)(wid * QBLK) * OST;
#pragma unroll
    for (int r = 0; r < 16; ++r) { const int orow = crow(r, hi);
#pragma unroll
        for (int d0 = 0; d0 < 4; ++d0) { const float v = o[d0][r] * rli[r];
            const float vn = __shfl_xor(v, 1);
            if ((r32 & 1) == 0) *(unsigned*)(Ow + (size_t)orow * OST + d0 * 32 + r32) = cvtpk(v, vn); } }
    __syncthreads();
#undef RESC
#undef KBASE
#undef MASKT
#undef SEAM_K0
#undef HALF_STEP
}
#undef ROW
#undef VMW
#undef VMWN
#undef SLOAD_H
#undef SWRITE_HK
#undef SWRITE_HV
#undef SWRITE_H
}

__device__ __forceinline__ void attn_phase(Frame& F, unsigned char* lds_generic) {
    const bf16_t* Qb = (const bf16_t*)(F.ws + WS_QKV); const bf16_t* Kb = Qb + (size_t)NH * T * DH; const bf16_t* Vb = Kb + (size_t)NH * T * DH;
    bf16_t* Ob = (bf16_t*)(F.ws + WS_CAT); const float* cks = (const float*)(F.ws + WS_CKS);
    constexpr int NQB = T / att::QB, NITEM = NH * (NQB / 2);
    char* lds = (char*)lds_generic;
    att::Seam S;
    bool primed = false;
    for (int L = blockIdx.x; L < NITEM; L += F.G) {
        const int xcd = L & 7, k = L >> 3, h = ((k >> 4) << 3) + xcd, y = k & 15;
        for (int pass = 0; pass < 2; ++pass) {
            const int qb = pass ? (NQB - 1 - y) : y;
            att::BlockRef cur; cur.Q = Qb + ((size_t)h * T + (size_t)qb * att::QB) * DH; cur.K = Kb + (size_t)h * T * DH; cur.V = Vb + (size_t)h * T * DH;
            cur.O = Ob + (size_t)qb * att::QB * D + h * DH; cur.ck = cks + (size_t)h * T; cur.P0 = qb * att::QB;
            att::BlockRef nxt = cur;
            if (pass == 0) { const int qn = NQB - 1 - y; nxt.Q = Qb + ((size_t)h * T + (size_t)qn * att::QB) * DH; nxt.P0 = qn * att::QB; nxt.O = Ob + (size_t)qn * att::QB * D + h * DH; }
            else if (L + F.G < NITEM) { const int L2 = L + F.G, x2 = L2 & 7, k2 = L2 >> 3, h2 = ((k2 >> 4) << 3) + x2, y2 = k2 & 15;
                nxt.Q = Qb + ((size_t)h2 * T + (size_t)y2 * att::QB) * DH; nxt.K = Kb + (size_t)h2 * T * DH; nxt.V = Vb + (size_t)h2 * T * DH; nxt.ck = cks + (size_t)h2 * T; nxt.P0 = y2 * att::QB;
                nxt.O = Ob + (size_t)y2 * att::QB * D + h2 * DH; }
            if (!primed) { att::fox_prime(cur, lds, S); primed = true; }
            att::fox_block(cur, nxt, lds, S);
        }
    }
    asm volatile("s_waitcnt vmcnt(0)" ::: "memory");
    __syncthreads();
}

struct EpiG4 {
    static constexpr bool PERM = true;
    bf16_t* qkv; const float* rr;
    __device__ __forceinline__ void operator()(const f32x4 (&acc)[2][2][4][2], const Unit& u, int wr, int wc, int fr, int fq) const {
#pragma unroll
        for (int ai = 0; ai < 2; ++ai)
#pragma unroll
            for (int m = 0; m < 4; ++m) { const int row = u.pm * BM + ai * HALF + wr * 64 + m * 16 + fr; const float sc = rr[row];
#pragma unroll
                for (int bj = 0; bj < 2; ++bj) { const int col = u.pn * BM + bj * HALF + wc * 32 + 8 * fq, which = col >> 11, hd = (col >> 7) & 15, d = col & 127;
                    const f32x4 v0 = acc[ai][bj][m][0] * sc, v1 = acc[ai][bj][m][1] * sc;
                    u32x4 w; w.x = cvt_pk_bf16(v0[0], v0[1]); w.y = cvt_pk_bf16(v0[2], v0[3]); w.z = cvt_pk_bf16(v1[0], v1[1]); w.w = cvt_pk_bf16(v1[2], v1[3]);
                    *(u32x4*)(qkv + ((size_t)(which * NH + hd) * T + row) * DH + d) = w; } }
    }
};
__device__ __forceinline__ void cumsum_phase(Frame& F) {
    if (blockIdx.x >= NH) return;
    const int h = blockIdx.x; const float* logf = (const float*)(F.ws + WS_LOGF); float* cks = (float*)(F.ws + WS_CKS) + (size_t)h * T;
    LAS float* wt = (LAS float*)F.lds;
    float v[16]; float s = 0.f;
#pragma unroll
    for (int i = 0; i < 16; ++i) { s += logf[(size_t)(F.tid * 16 + i) * NH + h]; v[i] = s; }
    float inc = s;
#pragma unroll
    for (int o = 1; o < 64; o <<= 1) { const float y = __shfl_up(inc, o); if (F.lane >= o) inc += y; }
    if (F.lane == 63) wt[F.wave] = inc;
    __syncthreads();
    float base = inc - s;
    for (int w = 0; w < F.wave; ++w) base += wt[w];
    const float k = 11.313708498984761f;
#pragma unroll
    for (int i = 0; i < 16; i += 4) *(f32x4*)(cks + F.tid * 16 + i) = (f32x4){(base + v[i]) * k, (base + v[i + 1]) * k, (base + v[i + 2]) * k, (base + v[i + 3]) * k};
    __syncthreads();
}

__global__ void __launch_bounds__(NWAVES * 64, 2) mk_fwd(Args args) {
    extern __shared__ __attribute__((aligned(16))) unsigned char lds_raw[];
    Frame F;
    F.lds = (LAS unsigned char*)lds_raw;
    F.MISC = (volatile LAS unsigned*)(F.lds + MISC_OFF);
    F.tid = threadIdx.x; F.lane = F.tid & 63; F.wave = __builtin_amdgcn_readfirstlane(F.tid >> 6);
    F.G = gridDim.x; { const int bx = blockIdx.x; F.vcu = (F.G % 8 == 0) ? (bx % 8) * (F.G / 8) + bx / 8 : bx; }
    F.ws = args.ws; F.ctl = (unsigned*)(args.ws + WS_CTL);
    for (int u = F.tid; u < (LDS_BYTES - LDSCTL_OFF) / 4; u += NWAVES * 64) ((LAS unsigned*)(F.lds + LDSCTL_OFF))[u] = 0u;
    __syncthreads();
    XcdBarrier bar = xcd_barrier_post(F.ctl + CW_BAR + args.li * XCD_BAR_WORDS, F.MISC + 8);
    const int lo = args.ph_lo, hi = args.ph_hi;
#ifdef MK_ONLY
#define IN(k) ((k) == MK_ONLY && lo <= (k) && (k) < hi)
#else
#define IN(k) (lo <= (k) && (k) < hi)
#endif
#define BOTH(k) (IN(k) && IN((k) + 1))
#define GRID_BAR() xcd_barrier(bar)

    if (IN(0)) {
        if (args.flags & PF_S5) p0_s5_tables(F, args);
        p0_small(F, args);
        p0_weights(F, args);
        p0_rows(F, args.in[0]);
        if (BOTH(0)) GRID_BAR();
    }
    if (IN(1)) {
        DenseOrder S; S.init(F.ws + WS_XB, (size_t)BM * D * 2, F.ws + WS_WIN0, (size_t)BM * D * 2, T, 4096, F.G, (int)blockIdx.x);
        EpiG1 E{(bf16_t*)(F.ws + WS_PROJ), (bf16_t*)(F.ws + WS_S5A), (const float*)(F.ws + WS_R)};
        gemm_phase<ARow, EpiG1, DenseOrder, true, false>(F.lds, D, ARow{D * 2}, S, E);
        if (BOTH(1)) GRID_BAR();
    }
    if (IN(2)) {
        BatchOrder S; S.A = (const char*)(F.ws + WS_S5A); S.B = (const char*)(F.ws + WS_MB); S.abatch = (size_t)NC * S5K * 2; S.bbatch = (size_t)256 * 512 * 2; S.bstep = 0;
        S.nN = 1; S.nwg = SG; S.G = F.G; S.c = (int)blockIdx.x;
        EpiS1 E{(float*)(F.ws + WS_S)};
        gemm_phase<ARow, EpiS1, BatchOrder, false, false>(F.lds, LC * SH, ARow{S5K * 2}, S, E);
        if (BOTH(2)) GRID_BAR();
    }
    if (IN(3)) { s5_scan(F); if (BOTH(3)) GRID_BAR(); }
    if (IN(4)) {
        BatchOrder S; S.A = (const char*)(F.ws + WS_S5A); S.B = (const char*)(F.ws + WS_TZ); S.abatch = (size_t)NC * S5K * 2; S.bbatch = (size_t)512 * S5K * 2; S.bstep = (size_t)256 * S5K * 2;
        S.nN = 2; S.nwg = SG * 2; S.G = F.G; S.c = (int)blockIdx.x;
        EpiS3 E{(const bf16_t*)(F.ws + WS_S5A), args.in[11], (bf16_t*)(F.ws + WS_YG)};
        gemm_phase<ARow, EpiS3, BatchOrder, false, false>(F.lds, S5K, ARow{S5K * 2}, S, E);
        if (F.G > 128) conv_phase(F, args, 128, F.G - 128); else conv_phase(F, args, 0, F.G);
        if (BOTH(4)) GRID_BAR();
    }
    if (IN(5)) {
        DenseOrder S; S.init(F.ws + WS_YG, (size_t)BM * 16 * 2, F.ws + WS_WGLU, (size_t)BM * SW * 2, T, SW, F.G, (int)blockIdx.x);
        EpiG2 E{(const bf16_t*)(F.ws + WS_YG), args.in[13], (bf16_t*)(F.ws + WS_CAT)};
        gemm_phase<AGroupMajor, EpiG2, DenseOrder, false, false>(F.lds, SW, AGroupMajor{}, S, E);
        if (BOTH(5)) GRID_BAR();
    }
    if (IN(6)) {
        DenseOrder S; S.init(F.ws + WS_CAT, (size_t)BM * D * 2, F.ws + WS_WOUT0, (size_t)BM * D * 2, T, D, F.G, (int)blockIdx.x);
        EpiRes E{args.in[0], (float*)(F.ws + WS_XA), (bf16_t*)(F.ws + WS_XB)};
        gemm_phase<ARow, EpiRes, DenseOrder, false, false>(F.lds, D, ARow{D * 2}, S, E);
        if (BOTH(6)) GRID_BAR();
    }
    if (IN(7)) { router_phase(F, args, 0); if (BOTH(7)) GRID_BAR(); }
    if (IN(8)) { moe_gemms_m1(F, 0); if (BOTH(8)) GRID_BAR(); }
    if (IN(9)) { moe_gemms_m2(F, 0); if (BOTH(9)) GRID_BAR(); }
    if (IN(10)) { combine_phase<0>(F, args); if (BOTH(10)) GRID_BAR(); }
    if (IN(11)) {
        cumsum_phase(F);
        DenseOrder S; S.init(F.ws + WS_XB, (size_t)BM * D * 2, F.ws + WS_WIN1, (size_t)BM * D * 2, T, 3 * D, F.G, (int)blockIdx.x);
        EpiG4 E{(bf16_t*)(F.ws + WS_QKV), (const float*)(F.ws + WS_R)};
        gemm_phase<ARow, EpiG4, DenseOrder, true, false>(F.lds, D, ARow{D * 2}, S, E);
        if (BOTH(11)) GRID_BAR();
    }
    if (IN(12)) { attn_phase(F, lds_raw); if (BOTH(12)) GRID_BAR(); }
    if (IN(13)) {
        DenseOrder S; S.init(F.ws + WS_CAT, (size_t)BM * D * 2, F.ws + WS_WOUT1, (size_t)BM * D * 2, T, D, F.G, (int)blockIdx.x);
        EpiRes E{(const float*)(F.ws + WS_XBB), (float*)(F.ws + WS_XA), (bf16_t*)(F.ws + WS_XB)};
        gemm_phase<ARow, EpiRes, DenseOrder, false, false>(F.lds, D, ARow{D * 2}, S, E);
        if (BOTH(13)) GRID_BAR();
    }
    if (IN(14)) { router_phase(F, args, 1); if (BOTH(14)) GRID_BAR(); }
    if (IN(15)) { moe_gemms_m1(F, 1); if (BOTH(15)) GRID_BAR(); }
    if (IN(16)) { moe_gemms_m2(F, 1); if (BOTH(16)) GRID_BAR(); }
    if (IN(17)) { combine_phase<1>(F, args); }
#undef IN
#undef BOTH
#undef GRID_BAR
}

static int g_grid = 0;
static bool mk_setup() {
    if (g_grid) return g_grid > 0;
    int dev = 0, cus = 0;
    if (hipGetDevice(&dev) != hipSuccess || hipDeviceGetAttribute(&cus, hipDeviceAttributeMultiprocessorCount, dev) != hipSuccess) { g_grid = -1; return false; }
    if (hipFuncSetAttribute((const void*)mk_fwd, hipFuncAttributeMaxDynamicSharedMemorySize, LDS_BYTES) != hipSuccess) { g_grid = -1; return false; }
    int per_cu = 0;
    (void)hipOccupancyMaxActiveBlocksPerMultiprocessor(&per_cu, (const void*)mk_fwd, NWAVES * 64, LDS_BYTES);
    (void)hipGetLastError();
    if (per_cu < 1) fprintf(stderr, "mk: occupancy query says %d blocks/CU\n", per_cu);
    g_grid = cus;
    return true;
}
static void mk_launch(hipStream_t stream, void* const* d_in, void* d_out, void* d_ws, int lo, int hi, int li, int flags) {
    Args a{};
    for (int i = 0; i < 28; ++i) a.in[i] = (const float*)d_in[i];
    a.out = (float*)d_out; a.ws = (unsigned char*)d_ws; a.ph_lo = lo; a.ph_hi = hi; a.li = li; a.flags = flags;
    hipLaunchKernelGGL(mk_fwd, dim3(g_grid), dim3(NWAVES * 64), LDS_BYTES, stream, a);
}
}

extern "C" void kernel_launch(void* const* d_in, const int* in_sizes, int n_in, void* d_out, int out_size, void* d_ws, size_t ws_size, hipStream_t stream) {
    (void)in_sizes; (void)n_in; (void)out_size;
    if (ws_size < mk::WS_END) { fprintf(stderr, "workspace too small: %zu\n", ws_size); return; }
    if (!mk::mk_setup()) { fprintf(stderr, "mk setup failed\n"); return; }
    (void)hipMemsetAsync((char*)d_ws + mk::WS_CTL, 0, mk::CTL_BYTES, stream);
    mk::mk_launch(stream, d_in, d_out, d_ws, 0, 18, 0, mk::PF_ALL);
}
```

```cpp
#include <hip/hip_runtime.h>
#include <stdint.h>
#include <stdio.h>

namespace mk {
#define LAS __attribute__((address_space(3)))
#define GAS __attribute__((address_space(1)))
typedef unsigned short bf16_t;
typedef short bf16x8 __attribute__((ext_vector_type(8)));
typedef short s16x4 __attribute__((ext_vector_type(4)));
typedef float f32x4 __attribute__((ext_vector_type(4)));
typedef float f32x2 __attribute__((ext_vector_type(2)));
typedef float f32x16 __attribute__((ext_vector_type(16)));
typedef unsigned u32x4 __attribute__((ext_vector_type(4)));
typedef unsigned u32x2 __attribute__((ext_vector_type(2)));

constexpr int T = 8192, D = 2048;
constexpr int CW = 1024, SW = 1024, SG = 64, SH = 16, SN = 64;
constexpr int LC = 32, NC = T / LC;
constexpr int S5K = LC * SH + 2 * SN;
constexpr int NH = 16, DH = 128;
constexpr int NE = 32, FF = 512;
constexpr int NWAVES = 8;
constexpr float EPS = 1e-6f;

constexpr size_t MiB = 1u << 20;
constexpr size_t WS_CTL = 0, CTL_BYTES = 1 * MiB;
constexpr size_t WS_WIN0 = 2 * MiB;
constexpr size_t WS_WGLU = 18 * MiB;
constexpr size_t WS_WOUT0 = 20 * MiB;
constexpr size_t WS_WIN1 = 28 * MiB;
constexpr size_t WS_WOUT1 = 52 * MiB;
constexpr size_t WS_WR = 60 * MiB;
constexpr size_t WS_WF = 61 * MiB;
constexpr size_t WS_LAM = 61 * MiB + 512 * 1024;
constexpr size_t WS_TZ = 62 * MiB;
constexpr size_t WS_MB = 102 * MiB;
constexpr size_t WS_WGU = 118 * MiB;
constexpr size_t WS_WD = 374 * MiB;
constexpr size_t WS_XB = 502 * MiB;
constexpr size_t WS_XA = 534 * MiB;
constexpr size_t WS_XBB = 598 * MiB;
constexpr size_t WS_R = 662 * MiB;
constexpr size_t WS_PROJ = 663 * MiB;
constexpr size_t WS_S5A = 711 * MiB;
constexpr size_t WS_S = 731 * MiB;
constexpr size_t WS_YG = 739 * MiB;
constexpr size_t WS_CAT = 755 * MiB;
constexpr size_t WS_QKV = 787 * MiB;
constexpr size_t WS_H = 883 * MiB;
constexpr size_t WS_Y = 900 * MiB;
constexpr size_t WS_LIST = 964 * MiB;
constexpr size_t WS_PW = 965 * MiB;
constexpr size_t WS_LOGF = 966 * MiB;
constexpr size_t WS_CKS = 967 * MiB;
constexpr size_t WS_END = 968 * MiB;
constexpr int CW_BAR = 4096;
constexpr int CW_CNT = 1024;
constexpr int MAX_LAUNCH = 24;
constexpr int CW_QUEUE = 2048;
constexpr int CW_FQ = 2112;
constexpr int CW_DONE = 2176;
constexpr int CW_KN2 = 131072;

constexpr int RING_BYTES = 131072;
constexpr int LDSCTL_OFF = RING_BYTES, MISC_OFF = LDSCTL_OFF + 320;
constexpr int LDS_BYTES = 147456;

#define LDS_WAIT() asm volatile("s_waitcnt lgkmcnt(0)" ::: "memory")
#define VM_WAIT() asm volatile("s_waitcnt vmcnt(0)" ::: "memory")

__device__ __forceinline__ unsigned cvt_pk_bf16(float lo, float hi) { unsigned r; asm volatile("v_cvt_pk_bf16_f32 %0, %1, %2" : "=v"(r) : "v"(lo), "v"(hi)); return r; }
__device__ __forceinline__ float bf2f(unsigned short b) { return __uint_as_float(((unsigned)b) << 16); }
__device__ __forceinline__ float bflo(unsigned w) { return __uint_as_float(w << 16); }
__device__ __forceinline__ float bfhi(unsigned w) { return __uint_as_float(w & 0xffff0000u); }
__device__ __forceinline__ int lane_id() { int l; asm volatile("v_mbcnt_lo_u32_b32 %0, -1, 0\n\tv_mbcnt_hi_u32_b32 %0, -1, %0" : "=v"(l)); return l; }
__device__ __forceinline__ float wave_sum(float v) {
#pragma unroll
    for (int o = 1; o < 64; o <<= 1) v += __shfl_xor(v, o);
    return v;
}
__device__ __forceinline__ float gelu_tanh_f(float y) {
    const float u = 0.7978845608028654f * (y + 0.044715f * y * y * y);
    return y / (1.f + __expf(-2.f * u));
}
__device__ __forceinline__ float sigmoid_f(float z) { return 1.f / (1.f + __expf(-z)); }

#define XB_TMO      128
#define XB_XCNT(j)  (256  + 64 * (j))
#define XB_XSUB(j)  (1280 + 64 * (j))
#define XB_XGEN(j)  (2304 + 64 * (j))
#define XB_TOP      3328
#define XB_TOPGEN   3392
#define XCD_BAR_WORDS 3456
#define XB_SPIN_CAP (1u << 18)
__device__ __forceinline__ unsigned xb_ld(unsigned* p)              { return __hip_atomic_load(p, __ATOMIC_RELAXED, __HIP_MEMORY_SCOPE_AGENT); }
__device__ __forceinline__ unsigned xb_add(unsigned* p, unsigned v) { return __hip_atomic_fetch_add(p, v, __ATOMIC_RELAXED, __HIP_MEMORY_SCOPE_AGENT); }
__device__ __forceinline__ unsigned xb_xcc_id() { return (unsigned)__builtin_amdgcn_s_getreg((3 << 11) | 20) & 0xFu; }
#define XB_SPIN(cond, bar) do { unsigned _sp = 0; while (cond) { __builtin_amdgcn_s_sleep(1); \
    if ((++_sp & 255u) == 0u) { if (xb_ld(&(bar)[XB_TMO])) break; if (_sp > XB_SPIN_CAP) { atomicAdd(&(bar)[XB_TMO], 1u); break; } } } } while (0)
struct XcdBarrier { unsigned* bar; unsigned x; volatile LAS unsigned* st; };
__device__ __forceinline__ XcdBarrier xcd_barrier_post(unsigned* bar, volatile LAS unsigned* st, int tid) {
    XcdBarrier b; b.bar = bar; b.x = xb_xcc_id(); b.st = st;
    if (tid == 0) (void)xb_add(&bar[XB_XCNT(b.x)], 1u);
    return b;
}
__device__ __forceinline__ void xcd_barrier_complete(unsigned* bar, unsigned x, unsigned& nloc, unsigned& nx) {
    const unsigned G = gridDim.x * gridDim.y * gridDim.z;
    unsigned sum, cnt, mine, sp = 0u;
    for (;;) {
        sum = 0u; cnt = 0u; mine = 0u;
#pragma unroll
        for (unsigned j = 0; j < 16; ++j) { const unsigned c = xb_ld(&bar[XB_XCNT(j)]); sum += c; cnt += (c > 0u) ? 1u : 0u; mine = (j == x) ? c : mine; }
        if (sum == G) break;
        __builtin_amdgcn_s_sleep(1);
        if ((++sp & 255u) == 0u) { if (xb_ld(&bar[XB_TMO])) break; if (sp > XB_SPIN_CAP) { atomicAdd(&bar[XB_TMO], 1u); break; } }
    }
    nloc = mine > 0u ? mine : 1u; nx = cnt > 0u ? cnt : 1u;
}
__device__ __forceinline__ void xcd_barrier(const XcdBarrier& b, int tid) {
    asm volatile("s_waitcnt vmcnt(0)" ::: "memory");
    __syncthreads();
    if (tid == 0) {
        unsigned* bar = b.bar;
        __builtin_amdgcn_s_waitcnt(0);
        unsigned nloc = b.st[0], nx = b.st[1];
        if (nloc == 0u) { xcd_barrier_complete(bar, b.x, nloc, nx); b.st[0] = nloc; b.st[1] = nx; }
        const unsigned old = xb_add(&bar[XB_XSUB(b.x)], 1u);
        const unsigned gen = old / nloc;
        if (old + 1u == (gen + 1u) * nloc) {
            __builtin_amdgcn_fence(__ATOMIC_RELEASE, "agent");
            asm volatile("s_waitcnt vmcnt(0)" ::: "memory");
            const unsigned og = xb_add(&bar[XB_TOP], 1u);
            const unsigned tg = og / nx;
            if (og + 1u == (tg + 1u) * nx) xb_add(&bar[XB_TOPGEN], 1u);
            else XB_SPIN(xb_ld(&bar[XB_TOPGEN]) == tg, bar);
            __builtin_amdgcn_fence(__ATOMIC_ACQUIRE, "agent");
            xb_add(&bar[XB_XGEN(b.x)], 1u);
            asm volatile("s_waitcnt vmcnt(0)" ::: "memory");
        } else {
            XB_SPIN(xb_ld(&bar[XB_XGEN(b.x)]) == gen, bar);
            __builtin_amdgcn_fence(__ATOMIC_ACQUIRE, "agent");
            asm volatile("s_waitcnt vmcnt(0)" ::: "memory");
        }
    }
    __syncthreads();
}

constexpr int BM = 256, BK = 64, HALF = 128, HTB = HALF * BK * 2, STAGE_BYTES = 8 * HTB, NXCD = 8, WGM = 8;
__host__ __device__ __forceinline__ int lds_byte(int r, int c) { const int st = (r >> 4) * 2 + (c >> 5), rr = r & 15, cc = c & 31, ob = rr * 64 + cc * 2; return st * 1024 + (ob ^ (((ob >> 9) & 1) << 5)); }
__host__ __device__ __forceinline__ void stage_rc(int b, int& R, int& C) { const int st = b / 1024, sb = b % 1024, swz = sb ^ (((sb >> 9) & 1) << 5); R = (st >> 1) * 16 + swz / 64; C = (st & 1) * 32 + (swz % 64) / 2; }
__host__ __device__ __forceinline__ int perm32(int rho) { const int n = rho >> 4, i = rho & 15; return 8 * (i >> 2) + 4 * n + (i & 3); }

struct Unit {
    const char* A;
    const char* B;
    const int* rows;
    int pm, pn, e, nvalid, aux;
};
struct ARow { int lda2; static constexpr bool PER_UNIT = false;
    __device__ __forceinline__ unsigned voff(const Unit&, int R, int C) const { return (unsigned)(R * lda2 + C * 2); }
    __device__ __forceinline__ size_t kstep() const { return 128; } };
struct AGather { int lda2; static constexpr bool PER_UNIT = true;
    __device__ __forceinline__ unsigned voff(const Unit& u, int R, int C) const { const int idx = R < u.nvalid ? R : 0; const int row = u.rows[idx] >> 1; return (unsigned)(row * lda2 + C * 2); }
    __device__ __forceinline__ size_t kstep() const { return 128; } };
struct AGroupMajor { static constexpr bool PER_UNIT = false;
    __device__ __forceinline__ unsigned voff(const Unit&, int R, int C) const { return (unsigned)((((C >> 4) * T + R) * 16 + (C & 15)) * 2); }
    __device__ __forceinline__ size_t kstep() const { return (size_t)4 * T * 16 * 2; } };

struct DenseOrder {
    const char* A; const char* B; size_t astep, bstep; int nM, nN, nwg, G, c;
    __device__ __forceinline__ void init(const void* A_, size_t astep_, const void* B_, size_t bstep_, int M, int N, int G_, int c_) {
        A = (const char*)A_; B = (const char*)B_; astep = astep_; bstep = bstep_; nM = M / BM; nN = N / BM; nwg = nM * nN; G = G_; c = c_; }
    __device__ __forceinline__ bool next(int i, Unit& u) const {
        const long L = (long)i * G + c; if (L >= nwg) return false;
        int wgid = (int)L; { const int q = nwg / NXCD, r = nwg % NXCD, xcd = wgid % NXCD, off = wgid / NXCD; wgid = (xcd < r ? xcd * (q + 1) : r * (q + 1) + (xcd - r) * q) + off; }
        const int nig = WGM * nN, gid = wgid / nig, fm = gid * WGM, gsz = (nM - fm) < WGM ? (nM - fm) : WGM;
        u.pm = fm + ((wgid % nig) % gsz); u.pn = (wgid % nig) / gsz; u.e = 0; u.nvalid = BM; u.rows = nullptr; u.aux = 0;
        u.A = A + (size_t)u.pm * astep; u.B = B + (size_t)u.pn * bstep; return true;
    }
};
struct BatchOrder {
    const char* A; const char* B; size_t abatch, bbatch, bstep; int nN, nwg, G, c;
    __device__ __forceinline__ bool next(int i, Unit& u) const {
        const long L = (long)i * G + c; if (L >= nwg) return false;
        u.e = (int)L / nN; u.pn = (int)L % nN; u.pm = 0; u.nvalid = BM; u.rows = nullptr; u.aux = 0;
        u.A = A + (size_t)u.e * abatch; u.B = B + (size_t)u.e * bbatch + (size_t)u.pn * bstep; return true;
    }
};

template <class AL, class Epi, class Sched, bool ALIGN_EPI, bool RAGGED>
__device__ __forceinline__ void gemm_phase(LAS unsigned char* lds, const int wid, const int K, const AL al, const Sched& S, const Epi& E) {
    const int lane = lane_id(), tid = wid * 64 + lane, wr = wid >> 2, wc = wid & 3, fr = lane & 15, fq = lane >> 4;
    const int nt = K / BK;
    unsigned voffB[2];
#pragma unroll
    for (int i = 0; i < 2; ++i) { int R, C; stage_rc(tid * 16 + i * 8192, R, C); const int Rb = Epi::PERM ? ((R & ~31) + perm32(R & 31)) : R; voffB[i] = (unsigned)(Rb * K + C) * 2u; }
    const size_t kstepA = al.kstep(), kstepB = (size_t)(BK * 2), hstepB = (size_t)HALF * K * 2;
    const unsigned ldsw = (unsigned)wid * 1024u;
    const int aoff = lds_byte(wr * 64 + fr, fq * 8), boff = lds_byte(wc * 32 + fr, fq * 8);
#define PG_SA(b, h) (((b) * 2 + (h)) * HTB)
#define PG_SB(b, h) ((4 + (b) * 2 + (h)) * HTB)
#define PG_STG(bufoff, gbase, v0, v1) do { \
        __builtin_amdgcn_global_load_lds((const unsigned*)((const char*)(gbase) + (v0)), (LAS unsigned*)(lds + (bufoff) + ldsw), 16, 0, 0); \
        __builtin_amdgcn_global_load_lds((const unsigned*)((const char*)(gbase) + (v1)), (LAS unsigned*)(lds + (bufoff) + ldsw + 8192), 16, 0, 0); } while (0)
#define PG_STGB(bufoff, gbase) PG_STG(bufoff, gbase, voffB[0], voffB[1])
#define PG_LDA(dst, b, h) do { _Pragma("unroll") for (int m = 0; m < 4; ++m) _Pragma("unroll") for (int k = 0; k < 2; ++k) dst[m][k] = *(const LAS bf16x8*)(lds + PG_SA(b, h) + aoff + m * 2048 + k * 1024); } while (0)
#define PG_LDB(dst, b, h) do { _Pragma("unroll") for (int n = 0; n < 2; ++n) _Pragma("unroll") for (int k = 0; k < 2; ++k) dst[n][k] = *(const LAS bf16x8*)(lds + PG_SB(b, h) + boff + n * 2048 + k * 1024); } while (0)
#define PG_MMA(ai, bj, At, Bt) do { __builtin_amdgcn_s_setprio(1); _Pragma("unroll") for (int m = 0; m < 4; ++m) _Pragma("unroll") for (int n = 0; n < 2; ++n) _Pragma("unroll") for (int k = 0; k < 2; ++k) \
        acc[ai][bj][m][n] = __builtin_amdgcn_mfma_f32_16x16x32_bf16(Bt[n][k], At[m][k], acc[ai][bj][m][n], 0, 0, 0); __builtin_amdgcn_s_setprio(0); } while (0)
#define PG_WAIT_V(n) asm volatile("s_waitcnt vmcnt(" #n ")" ::: "memory")
#define PG_WAIT_L(n) asm volatile("s_waitcnt lgkmcnt(" #n ")" ::: "memory")
#define PG_BAR __builtin_amdgcn_s_barrier()
#define PG_SCHED __builtin_amdgcn_sched_barrier(0)
    Unit cur, nxt; int ui = 0;
    if (!S.next(0, cur)) return;
    unsigned vA[2][2];
#pragma unroll
    for (int h = 0; h < 2; ++h)
#pragma unroll
        for (int i = 0; i < 2; ++i) { int R, C; stage_rc((wid * 64 + lane_id()) * 16 + i * 8192, R, C); vA[h][i] = al.voff(cur, h * HALF + R, C); }
    f32x4 acc[2][2][4][2];
#pragma unroll
    for (int a = 0; a < 2; ++a)
#pragma unroll
        for (int b = 0; b < 2; ++b)
#pragma unroll
            for (int m = 0; m < 4; ++m)
#pragma unroll
                for (int n = 0; n < 2; ++n) acc[a][b][m][n] = (f32x4){0.f, 0.f, 0.f, 0.f};
    bf16x8 At[4][2], B0[2][2], B1[2][2];
    const char* cA = cur.A; const char* cB = cur.B;
    PG_STGB(PG_SB(0, 0), cB); PG_STGB(PG_SB(0, 1), cB + hstepB); PG_STG(PG_SA(0, 0), cA, vA[0][0], vA[0][1]); PG_STG(PG_SA(0, 1), cA, vA[1][0], vA[1][1]);
    if (wr == 1) PG_BAR;
    PG_WAIT_V(2); PG_BAR;
    PG_STGB(PG_SB(1, 0), cB + kstepB); PG_STG(PG_SA(1, 0), cA + kstepA, vA[0][0], vA[0][1]); PG_STGB(PG_SB(1, 1), cB + hstepB + kstepB);
    PG_WAIT_V(6); PG_BAR;
    for (;;) {
        const bool has_next = S.next(ui + 1, nxt);
        const char* nA = has_next ? nxt.A : cA; const char* nB = has_next ? nxt.B : cB;
        for (int t = 0; t < nt; t += 2) {
            const bool last = (t == nt - 2);
            const char* a1 = cA + (size_t)(t + 1) * kstepA;
            const char* a2 = last ? nA : cA + (size_t)(t + 2) * kstepA; const char* b2 = last ? nB : cB + (size_t)(t + 2) * kstepB;
            const char* a3 = a2 + kstepA; const char* b3 = b2 + kstepB;
            const bool up = !RAGGED || cur.nvalid > HALF;
            PG_LDB(B0, 0, 0); PG_LDB(B1, 0, 1); PG_SCHED; PG_LDA(At, 0, 0); PG_STG(PG_SA(1, 1), a1, vA[1][0], vA[1][1]);
            if constexpr (AL::PER_UNIT) {
                if (last && has_next) {
#pragma unroll
                    for (int h = 0; h < 2; ++h)
#pragma unroll
                        for (int i = 0; i < 2; ++i) { int R, C; stage_rc((wid * 64 + lane_id()) * 16 + i * 8192, R, C); vA[h][i] = al.voff(nxt, h * HALF + R, C); }
                }
            }
            PG_WAIT_V(8); PG_WAIT_L(0); PG_BAR; PG_MMA(0, 0, At, B0); PG_MMA(0, 1, At, B1); PG_BAR; PG_SCHED;
            PG_LDA(At, 0, 1); PG_STGB(PG_SB(0, 0), b2); PG_STGB(PG_SB(0, 1), b2 + hstepB); PG_STG(PG_SA(0, 0), a2, vA[0][0], vA[0][1]);
            PG_WAIT_V(8); PG_WAIT_L(0); PG_BAR; if (up) { PG_MMA(1, 0, At, B0); PG_MMA(1, 1, At, B1); } PG_BAR; PG_SCHED;
            PG_LDB(B0, 1, 0); PG_LDB(B1, 1, 1); PG_SCHED; PG_LDA(At, 1, 0); PG_STG(PG_SA(0, 1), a2, vA[1][0], vA[1][1]);
            PG_WAIT_V(8); PG_WAIT_L(0); PG_BAR; PG_MMA(0, 0, At, B0); PG_MMA(0, 1, At, B1); PG_BAR; PG_SCHED;
            PG_LDA(At, 1, 1); PG_STGB(PG_SB(1, 0), b3); PG_STGB(PG_SB(1, 1), b3 + hstepB); PG_STG(PG_SA(1, 0), a3, vA[0][0], vA[0][1]);
            PG_WAIT_V(8); PG_WAIT_L(0); PG_BAR; if (up) { PG_MMA(1, 0, At, B0); PG_MMA(1, 1, At, B1); } PG_BAR; PG_SCHED;
        }
        if constexpr (ALIGN_EPI) { if (wr == 0) PG_BAR; }
        E(acc, cur, wr, wc, fr, fq);
        if (!has_next) break;
#pragma unroll
        for (int a = 0; a < 2; ++a)
#pragma unroll
            for (int b = 0; b < 2; ++b)
#pragma unroll
                for (int m = 0; m < 4; ++m)
#pragma unroll
                    for (int n = 0; n < 2; ++n) acc[a][b][m][n] = (f32x4){0.f, 0.f, 0.f, 0.f};
        cur = nxt; cA = nA; cB = nB; ++ui;
        if constexpr (ALIGN_EPI) { if (wr == 1) PG_BAR; }
    }
    PG_WAIT_V(0);
    if constexpr (!ALIGN_EPI) { if (wr == 0) PG_BAR; }
    PG_BAR;
#undef PG_SA
#undef PG_SB
#undef PG_STG
#undef PG_STGB
#undef PG_LDA
#undef PG_LDB
#undef PG_MMA
#undef PG_WAIT_V
#undef PG_WAIT_L
#undef PG_BAR
#undef PG_SCHED
}

struct Args { const float* in[28]; float* out; unsigned char* ws; int ph_lo, ph_hi, li, flags; };
struct Frame {
    LAS unsigned char* lds; volatile LAS unsigned* MISC; unsigned* ctl; unsigned char* ws;
    int wave, vcu, G;
    __device__ __forceinline__ int lane() const { return lane_id(); }
    __device__ __forceinline__ int tid() const { return wave * 64 + lane_id(); }
};

template <bool GAIN, class RowMap>
__device__ __forceinline__ void tr_item(const float* W, int ldw, int K, bf16_t* WT, const float* gain, LAS float* scr, int kb, int nb, int lane, RowMap rm) {
    const int k0 = 64 * kb, n0 = 32 * nb;
    float gv = 1.f; if constexpr (GAIN) gv = gain[k0 + lane];
#pragma unroll 8
    for (int i = 0; i < 32; ++i) { const int kk = 2 * i + (lane >> 5); float v = W[(size_t)(k0 + kk) * ldw + n0 + (lane & 31)]; if constexpr (GAIN) v *= __shfl(gv, kk); scr[kk * 33 + (lane & 31)] = v; }
    LDS_WAIT(); asm volatile("" ::: "memory");
    const int c = lane & 7;
#pragma unroll
    for (int j = 0; j < 4; ++j) { const int n = (lane >> 3) + 8 * j; const LAS float* s = scr + (8 * c) * 33 + n;
        u32x4 o; o.x = cvt_pk_bf16(s[0 * 33], s[1 * 33]); o.y = cvt_pk_bf16(s[2 * 33], s[3 * 33]); o.z = cvt_pk_bf16(s[4 * 33], s[5 * 33]); o.w = cvt_pk_bf16(s[6 * 33], s[7 * 33]);
        *(u32x4*)(WT + (size_t)rm(n0 + n) * K + k0 + 8 * c) = o; }
    LDS_WAIT(); asm volatile("" ::: "memory");
}
struct RmId { __device__ __forceinline__ int operator()(int n) const { return n; } };
struct RmGU { int up; __device__ __forceinline__ int operator()(int n) const { return ((n >> 7) << 8) + up * 128 + (n & 127); } };

constexpr int PF_L0 = 1, PF_S5 = 2, PF_L1 = 4, PF_MOE = 8, PF_ALL = 15, PF_MOE0 = 16;

constexpr int MOE_IG = (D / 64) * (FF / 32), MOE_ID = (FF / 64) * (D / 32), MOE_PER_EXP = 2 * MOE_IG + MOE_ID;
constexpr int MOE_ITEMS = 64 * MOE_PER_EXP, MOE_L1_BASE = MOE_ITEMS / 2, FQ_CLAIM = 16, FQ_TOTAL = (MOE_ITEMS / 2) / FQ_CLAIM;
__device__ __forceinline__ void moe_weight_item(Frame& F, const Args& a, int r, LAS float* scr) {
    bf16_t* wgu = (bf16_t*)(F.ws + WS_WGU); bf16_t* wd = (bf16_t*)(F.ws + WS_WD);
    const int le = r / MOE_PER_EXP; int q = r % MOE_PER_EXP; const int layer = le >> 5;
    const float* gain = a.in[19] + (size_t)layer * D;
    if (q < MOE_IG) { tr_item<true>(a.in[24] + (size_t)le * D * FF, FF, D, wgu + (size_t)le * 1024 * D, gain, scr, q / 16, q % 16, F.lane(), RmGU{0}); return; } q -= MOE_IG;
    if (q < MOE_IG) { tr_item<true>(a.in[25] + (size_t)le * D * FF, FF, D, wgu + (size_t)le * 1024 * D, gain, scr, q / 16, q % 16, F.lane(), RmGU{1}); return; } q -= MOE_IG;
    tr_item<false>(a.in[26] + (size_t)le * FF * D, D, FF, wd + (size_t)le * D * FF, nullptr, scr, q / 64, q % 64, F.lane(), RmId{});
}
#ifndef FILLMASK
#define FILLMASK 4
#endif
__device__ __forceinline__ void filler(Frame& F, const Args& a, unsigned* done, unsigned total) {
    LAS float* scr = (LAS float*)(F.lds + F.wave * 16384);
    volatile LAS int* slot = (volatile LAS int*)(F.lds + LDSCTL_OFF) + 72;
    unsigned* fq = F.ctl + CW_FQ;
    const int tid = F.tid();
    int cn = -1; bool stopping = false;
    if (tid == 0) {
        const bool fin = done && __hip_atomic_load(done, __ATOMIC_RELAXED, __HIP_MEMORY_SCOPE_AGENT) >= total;
        if (!fin && (int)__hip_atomic_load(fq, __ATOMIC_RELAXED, __HIP_MEMORY_SCOPE_AGENT) < FQ_TOTAL) cn = (int)__hip_atomic_fetch_add(fq, 1u, __ATOMIC_RELAXED, __HIP_MEMORY_SCOPE_AGENT);
        if (cn >= FQ_TOTAL) cn = -1;
    }
    for (;;) {
        if (tid == 0) slot[0] = cn;
        __syncthreads();
        const int c = __builtin_amdgcn_readfirstlane(slot[0]);
        __syncthreads();
        if (c < 0) break;
        unsigned dn = 0; int cn2 = -1;
        if (tid == 0 && !stopping) {
            if (done) dn = __hip_atomic_load(done, __ATOMIC_RELAXED, __HIP_MEMORY_SCOPE_AGENT);
            cn2 = (int)__hip_atomic_fetch_add(fq, 1u, __ATOMIC_RELAXED, __HIP_MEMORY_SCOPE_AGENT);
        }
#pragma unroll 1
        for (int i = 0; i < FQ_CLAIM / NWAVES; ++i) moe_weight_item(F, a, MOE_L1_BASE + c * FQ_CLAIM + F.wave * (FQ_CLAIM / NWAVES) + i, scr);
        if (tid == 0) { if (cn2 >= FQ_TOTAL) cn2 = -1; if (done && dn >= total) stopping = true; cn = cn2; }
    }
}
__device__ __forceinline__ void phase_done(Frame& F, int phase, unsigned n) {
    if (F.tid() == 0 && n) __hip_atomic_fetch_add(F.ctl + CW_DONE + 64 * phase, n, __ATOMIC_RELAXED, __HIP_MEMORY_SCOPE_AGENT);
}
__device__ __forceinline__ void p0_weights(Frame& F, const Args& a) {
    LAS float* scr = (LAS float*)(F.lds + F.wave * 16384);
    const int gw = F.vcu * NWAVES + F.wave, NGW = F.G * NWAVES;
    bf16_t* win0 = (bf16_t*)(F.ws + WS_WIN0); bf16_t* wglu = (bf16_t*)(F.ws + WS_WGLU); bf16_t* wout0 = (bf16_t*)(F.ws + WS_WOUT0);
    bf16_t* win1 = (bf16_t*)(F.ws + WS_WIN1); bf16_t* wout1 = (bf16_t*)(F.ws + WS_WOUT1); bf16_t* wgu = (bf16_t*)(F.ws + WS_WGU); bf16_t* wd = (bf16_t*)(F.ws + WS_WD);
    constexpr int I_IN0 = (D / 64) * (4096 / 32), I_GLU = (SW / 64) * (SW / 32), I_OUT = (D / 64) * (D / 32), I_IN1 = (D / 64) * (6144 / 32);
    const int n_l0 = (a.flags & PF_L0) ? (I_IN0 + I_GLU + I_OUT) : 0;
    const int n_l1 = (a.flags & PF_L1) ? (I_IN1 + I_OUT) : 0;
    const int n_moe = (a.flags & PF_MOE) ? MOE_ITEMS : ((a.flags & PF_MOE0) ? MOE_ITEMS / 2 : 0);
    const int total = n_l0 + n_l1 + n_moe;
    for (int it = gw; it < total; it += NGW) {
        int r = it;
        if (r < n_l0) {
            if (r < I_IN0) { tr_item<true>(a.in[2], 4096, D, win0, a.in[1], scr, r / 128, r % 128, F.lane(), RmId{}); continue; } r -= I_IN0;
            if (r < I_GLU) { tr_item<false>(a.in[12], SW, SW, wglu, nullptr, scr, r / 32, r % 32, F.lane(), RmId{}); continue; } r -= I_GLU;
            tr_item<false>(a.in[14], D, D, wout0, nullptr, scr, r / 64, r % 64, F.lane(), RmId{}); continue;
        }
        r -= n_l0;
        if (r < n_l1) {
            if (r < I_IN1) { tr_item<true>(a.in[16], 3 * D + NH, D, win1, a.in[15], scr, r / 192, r % 192, F.lane(), RmId{}); continue; } r -= I_IN1;
            tr_item<false>(a.in[18], D, D, wout1, nullptr, scr, r / 64, r % 64, F.lane(), RmId{}); continue;
        }
        r -= n_l1;
        moe_weight_item(F, a, r, scr);
    }
}
__device__ __forceinline__ void p0_rows(Frame& F, const float* x) {
    const int lane = F.lane();
    const int gw = F.vcu * NWAVES + F.wave, NGW = F.G * NWAVES;
    bf16_t* xb = (bf16_t*)(F.ws + WS_XB); float* rr = (float*)(F.ws + WS_R);
    for (int m = gw; m < T; m += NGW) {
        const f32x4* xr = (const f32x4*)(x + (size_t)m * D) + lane;
        f32x4 v[8]; float s = 0.f;
#pragma unroll
        for (int j = 0; j < 8; ++j) { v[j] = xr[64 * j]; s += (v[j].x * v[j].x + v[j].y * v[j].y) + (v[j].z * v[j].z + v[j].w * v[j].w); }
        s = wave_sum(s);
        u32x2* o = (u32x2*)(xb + (size_t)m * D) + lane;
#pragma unroll
        for (int j = 0; j < 8; ++j) { u32x2 w; w.x = cvt_pk_bf16(v[j].x, v[j].y); w.y = cvt_pk_bf16(v[j].z, v[j].w); o[64 * j] = w; }
        if (lane == 0) rr[m] = rsqrtf(s * (1.f / D) + EPS);
    }
}

struct EpiG1 {
    static constexpr bool PERM = true;
    bf16_t* proj; bf16_t* s5a; const float* rr;
    __device__ __forceinline__ void operator()(const f32x4 (&acc)[2][2][4][2], const Unit& u, int wr, int wc, int fr, int fq) const {
        const int row0 = u.pm * BM + wr * 64 + fr, col0 = u.pn * BM + wc * 32 + 8 * fq;
#pragma unroll
        for (int ai = 0; ai < 2; ++ai)
#pragma unroll
            for (int m = 0; m < 4; ++m) {
                const int row = row0 + ai * HALF + m * 16; const float sc = rr[row];
#pragma unroll
                for (int bj = 0; bj < 2; ++bj) {
                    const f32x4 v0 = acc[ai][bj][m][0] * sc, v1 = acc[ai][bj][m][1] * sc;
                    u32x4 w; w.x = cvt_pk_bf16(v0[0], v0[1]); w.y = cvt_pk_bf16(v0[2], v0[3]); w.z = cvt_pk_bf16(v1[0], v1[1]); w.w = cvt_pk_bf16(v1[2], v1[3]);
                    const int col = col0 + bj * HALF;
                    if (u.pn < 12) *(u32x4*)(proj + (size_t)row * 3072 + col) = w;
                    else { const int cc = col - 3072, g = cc >> 4, h0 = cc & 15, c = row >> 5, j = row & 31;
                           *(u32x4*)(s5a + ((size_t)(g * NC + c)) * S5K + j * 16 + h0) = w; }
                }
            }
    }
};


__device__ __forceinline__ void p0_s5_tables(Frame& F, const Args& a) {
    LAS float* pwr = (LAS float*)F.lds;
    LAS float* pwi = pwr + 64 * 33;
    LAS float* bbr = pwi + 64 * 33;
    LAS float* bbi = bbr + 64 * 16;
    LAS float* ctr = bbi + 64 * 16;
    LAS float* cti = ctr + 64 * 16;
    LAS float* Kt  = cti + 64 * 16;
    bf16_t* tz = (bf16_t*)(F.ws + WS_TZ); bf16_t* mb = (bf16_t*)(F.ws + WS_MB); float* lam32 = (float*)(F.ws + WS_LAM);
    const int tid = F.tid();
    for (int item = blockIdx.x; item < SG * 4; item += F.G) {
        const int g = item >> 2, q = item & 3;
        __syncthreads();
        const float dt = __expf(a.in[6][g]);
        for (int idx = tid; idx < 64 * 33; idx += NWAVES * 64) {
            const int n = idx / 33, tau = idx % 33;
            const float lr = a.in[4][g * SN + n], li = a.in[5][g * SN + n];
            const float mag = expf(lr * dt * (float)tau), ang = li * dt * (float)tau;
            pwr[idx] = mag * cosf(ang); pwi[idx] = mag * sinf(ang);
        }
        for (int idx = tid; idx < 64 * 16; idx += NWAVES * 64) {
            const int n = idx >> 4, h = idx & 15;
            const float lr = a.in[4][g * SN + n], li = a.in[5][g * SN + n];
            const float er = expf(lr * dt), ar = er * cosf(li * dt), ai = er * sinf(li * dt);
            const float nr = ar - 1.f, ni = ai, den = lr * lr + li * li;
            const float cr = (nr * lr + ni * li) / den, ci = (ni * lr - nr * li) / den;
            const float xr = a.in[7][((size_t)g * SN + n) * SH + h], xi = a.in[8][((size_t)g * SN + n) * SH + h];
            bbr[idx] = cr * xr - ci * xi; bbi[idx] = cr * xi + ci * xr;
            ctr[idx] = a.in[9][((size_t)g * SH + h) * SN + n]; cti[idx] = a.in[10][((size_t)g * SH + h) * SN + n];
        }
        __syncthreads();
        if (q == 0 && tid < 64) { lam32[(g * 64 + tid) * 2] = pwr[tid * 33 + 32]; lam32[(g * 64 + tid) * 2 + 1] = pwi[tid * 33 + 32]; }
        {
            const int tau = tid >> 4, hb = ((tid >> 2) & 3) * 4, hpb = (tid & 3) * 4;
            float acc[4][4];
#pragma unroll
            for (int i = 0; i < 4; ++i)
#pragma unroll
                for (int j = 0; j < 4; ++j) acc[i][j] = 0.f;
            for (int n = 0; n < 64; ++n) {
                const float pr = pwr[n * 33 + tau], pi = pwi[n * 33 + tau];
                const f32x4 cr = *(const LAS f32x4*)(ctr + n * 16 + hb), ci = *(const LAS f32x4*)(cti + n * 16 + hb);
                const f32x4 br = *(const LAS f32x4*)(bbr + n * 16 + hpb), bi = *(const LAS f32x4*)(bbi + n * 16 + hpb);
                const f32x4 mr = br * pr - bi * pi, mi = br * pi + bi * pr;
#pragma unroll
                for (int i = 0; i < 4; ++i)
#pragma unroll
                    for (int j = 0; j < 4; ++j) acc[i][j] += cr[i] * mr[j] - ci[i] * mi[j];
            }
#pragma unroll
            for (int i = 0; i < 4; ++i) *(LAS f32x4*)(Kt + (tau * 16 + hb + i) * 16 + hpb) = (f32x4){acc[i][0], acc[i][1], acc[i][2], acc[i][3]};
        }
        __syncthreads();
        for (int pz = tid; pz < 128 * 80; pz += NWAVES * 64) {
            const int rl = pz / 80, pc = pz % 80, row = 128 * q + rl, j = row >> 4, h = row & 15;
            float v[8];
            if (pc < 64) {
                const int jp = pc >> 1, hp0 = (pc & 1) * 8;
                if (jp <= j) { const LAS float* kp = Kt + (((j - jp) * 16 + h) * 16 + hp0);
#pragma unroll
                    for (int i = 0; i < 8; ++i) v[i] = kp[i]; }
                else {
#pragma unroll
                    for (int i = 0; i < 8; ++i) v[i] = 0.f; }
            } else {
                const int m0 = (pc - 64) * 8;
#pragma unroll
                for (int i = 0; i < 8; ++i) { const int m = (m0 + i) & 63; const float cr = ctr[m * 16 + h], ci = cti[m * 16 + h], pr = pwr[m * 33 + j + 1], pi = pwi[m * 33 + j + 1];
                    v[i] = (m0 < 64) ? (cr * pr - ci * pi) : -(cr * pi + ci * pr); }
            }
            u32x4 o; o.x = cvt_pk_bf16(v[0], v[1]); o.y = cvt_pk_bf16(v[2], v[3]); o.z = cvt_pk_bf16(v[4], v[5]); o.w = cvt_pk_bf16(v[6], v[7]);
            *(u32x4*)(tz + ((size_t)g * 512 + row) * S5K + pc * 8) = o;
        }
        for (int pz = tid; pz < 64 * 64; pz += NWAVES * 64) {
            const int rl = pz >> 6, pc = pz & 63, row = 64 * q + rl;
            float v[8];
            if (row < 128) {
                const int n = row & 63, jp = pc >> 1, hp0 = (pc & 1) * 8; const float pr = pwr[n * 33 + (LC - 1 - jp)], pi = pwi[n * 33 + (LC - 1 - jp)];
#pragma unroll
                for (int i = 0; i < 8; ++i) { const float br = bbr[n * 16 + hp0 + i], bi = bbi[n * 16 + hp0 + i]; v[i] = (row < 64) ? (pr * br - pi * bi) : (pr * bi + pi * br); }
            } else {
#pragma unroll
                for (int i = 0; i < 8; ++i) v[i] = 0.f; }
            u32x4 o; o.x = cvt_pk_bf16(v[0], v[1]); o.y = cvt_pk_bf16(v[2], v[3]); o.z = cvt_pk_bf16(v[4], v[5]); o.w = cvt_pk_bf16(v[6], v[7]);
            *(u32x4*)(mb + ((size_t)g * 256 + row) * 512 + pc * 8) = o;
        }
    }
    __syncthreads();
}

__device__ __forceinline__ void s5_scan(Frame& F) {
    if (F.wave != 0) return;
    const float* S = (const float*)(F.ws + WS_S); const float* lam32 = (const float*)(F.ws + WS_LAM); bf16_t* s5a = (bf16_t*)(F.ws + WS_S5A);
    for (int g = blockIdx.x; g < SG; g += F.G) {
        const int n = F.lane();
        const float ar = lam32[(g * 64 + n) * 2], ai = lam32[(g * 64 + n) * 2 + 1];
        float sr = 0.f, si = 0.f;
        const float* Sg = S + (size_t)g * NC * 128 + n; bf16_t* xg = s5a + (size_t)g * NC * S5K + LC * SH + n;
#pragma unroll 8
        for (int c = 0; c < NC; ++c) {
            const float pr = Sg[(size_t)c * 128], pi = Sg[(size_t)c * 128 + 64];
            xg[(size_t)c * S5K] = (bf16_t)(cvt_pk_bf16(sr, sr) & 0xffffu); xg[(size_t)c * S5K + 64] = (bf16_t)(cvt_pk_bf16(si, si) & 0xffffu);
            const float nsr = ar * sr - ai * si + pr, nsi = ar * si + ai * sr + pi;
            sr = nsr; si = nsi;
        }
    }
}

__device__ __forceinline__ void conv_phase(Frame& F, const Args& a, int wg0, int nwg) {
    const bf16_t* proj = (const bf16_t*)(F.ws + WS_PROJ); bf16_t* cat = (bf16_t*)(F.ws + WS_CAT);
    const int wgi = (int)blockIdx.x - wg0; if (wgi < 0) return;
    constexpr int TT = 16, NTASK = (T / TT) * 128;
    for (int task = wgi * (NWAVES * 64) + F.tid(); task < NTASK; task += nwg * NWAVES * 64) {
        const int c8 = task & 127, t0 = (task >> 7) * TT, c0 = c8 * 8;
        float w[3][8];
#pragma unroll
        for (int k = 0; k < 3; ++k) { const f32x4 w0 = *(const f32x4*)(a.in[3] + k * CW + c0), w1 = *(const f32x4*)(a.in[3] + k * CW + c0 + 4);
#pragma unroll
            for (int i = 0; i < 4; ++i) { w[k][i] = w0[i]; w[k][4 + i] = w1[i]; } }
        float v1[8], v2[8];
#pragma unroll
        for (int i = 0; i < 8; ++i) { v1[i] = 0.f; v2[i] = 0.f; }
        for (int dtt = -2; dtt < TT; ++dtt) {
            const int t = t0 + dtt; if (t < 0) continue;
            const bf16_t* pr = proj + (size_t)t * 3072 + c0;
            const u32x4 gc = *(const u32x4*)(pr + CW), uu = *(const u32x4*)(pr + 2 * CW);
            float v[8];
#pragma unroll
            for (int i = 0; i < 4; ++i) { v[2 * i] = bflo(gc[i]) * bflo(uu[i]); v[2 * i + 1] = bfhi(gc[i]) * bfhi(uu[i]); }
            if (dtt >= 0) {
                const u32x4 gb = *(const u32x4*)pr; float o[8];
#pragma unroll
                for (int i = 0; i < 4; ++i) { o[2 * i] = bflo(gb[i]) * (w[0][2 * i] * v2[2 * i] + w[1][2 * i] * v1[2 * i] + w[2][2 * i] * v[2 * i]);
                                              o[2 * i + 1] = bfhi(gb[i]) * (w[0][2 * i + 1] * v2[2 * i + 1] + w[1][2 * i + 1] * v1[2 * i + 1] + w[2][2 * i + 1] * v[2 * i + 1]); }
                u32x4 ow; ow.x = cvt_pk_bf16(o[0], o[1]); ow.y = cvt_pk_bf16(o[2], o[3]); ow.z = cvt_pk_bf16(o[4], o[5]); ow.w = cvt_pk_bf16(o[6], o[7]);
                *(u32x4*)(cat + (size_t)t * D + c0) = ow;
            }
#pragma unroll
            for (int i = 0; i < 8; ++i) { v2[i] = v1[i]; v1[i] = v[i]; }
        }
    }
}

struct EpiS1 {
    static constexpr bool PERM = false;
    float* S;
    __device__ __forceinline__ void operator()(const f32x4 (&acc)[2][2][4][2], const Unit& u, int wr, int wc, int fr, int fq) const {
#pragma unroll
        for (int ai = 0; ai < 2; ++ai)
#pragma unroll
            for (int m = 0; m < 4; ++m) { const int row = ai * HALF + wr * 64 + m * 16 + fr;
#pragma unroll
                for (int n = 0; n < 2; ++n) *(f32x4*)(S + ((size_t)u.e * NC + row) * 128 + wc * 32 + 16 * n + 4 * fq) = acc[ai][0][m][n]; }
    }
};
struct EpiS3 {
    static constexpr bool PERM = true;
    const bf16_t* s5a; const float* dvec; bf16_t* yg;
    __device__ __forceinline__ void operator()(const f32x4 (&acc)[2][2][4][2], const Unit& u, int wr, int wc, int fr, int fq) const {
        const int g = u.e;
#pragma unroll
        for (int bj = 0; bj < 2; ++bj) {
            const int col = u.pn * BM + bj * HALF + wc * 32 + 8 * fq, h0 = col & 15;
            const f32x4 d0 = *(const f32x4*)(dvec + g * 16 + h0), d1 = *(const f32x4*)(dvec + g * 16 + h0 + 4);
#pragma unroll
            for (int ai = 0; ai < 2; ++ai)
#pragma unroll
                for (int m = 0; m < 4; ++m) { const int row = ai * HALF + wr * 64 + m * 16 + fr;
                    const u32x4 uu = *(const u32x4*)(s5a + ((size_t)g * NC + row) * S5K + col);
                    const f32x4 a0 = acc[ai][bj][m][0], a1 = acc[ai][bj][m][1];
                    float y[8];
                    y[0] = a0[0] + d0[0] * bflo(uu.x); y[1] = a0[1] + d0[1] * bfhi(uu.x); y[2] = a0[2] + d0[2] * bflo(uu.y); y[3] = a0[3] + d0[3] * bfhi(uu.y);
                    y[4] = a1[0] + d1[0] * bflo(uu.z); y[5] = a1[1] + d1[1] * bfhi(uu.z); y[6] = a1[2] + d1[2] * bflo(uu.w); y[7] = a1[3] + d1[3] * bfhi(uu.w);
#pragma unroll
                    for (int i = 0; i < 8; ++i) y[i] = gelu_tanh_f(y[i]);
                    u32x4 w; w.x = cvt_pk_bf16(y[0], y[1]); w.y = cvt_pk_bf16(y[2], y[3]); w.z = cvt_pk_bf16(y[4], y[5]); w.w = cvt_pk_bf16(y[6], y[7]);
                    *(u32x4*)(yg + ((size_t)g * NC + row) * 512 + col) = w; }
        }
    }
};
struct EpiG2 {
    static constexpr bool PERM = true;
    const bf16_t* yg; const float* bias; bf16_t* cat;
    __device__ __forceinline__ void operator()(const f32x4 (&acc)[2][2][4][2], const Unit& u, int wr, int wc, int fr, int fq) const {
#pragma unroll
        for (int bj = 0; bj < 2; ++bj) {
            const int col = u.pn * BM + bj * HALF + wc * 32 + 8 * fq;
            const f32x4 b0 = *(const f32x4*)(bias + col), b1 = *(const f32x4*)(bias + col + 4);
#pragma unroll
            for (int ai = 0; ai < 2; ++ai)
#pragma unroll
                for (int m = 0; m < 4; ++m) { const int t = u.pm * BM + ai * HALF + wr * 64 + m * 16 + fr;
                    const u32x4 yy = *(const u32x4*)(yg + ((size_t)(col >> 4) * T + t) * 16 + (col & 15));
                    const f32x4 z0 = acc[ai][bj][m][0] + b0, z1 = acc[ai][bj][m][1] + b1;
                    float o[8];
                    o[0] = bflo(yy.x) * sigmoid_f(z0[0]); o[1] = bfhi(yy.x) * sigmoid_f(z0[1]); o[2] = bflo(yy.y) * sigmoid_f(z0[2]); o[3] = bfhi(yy.y) * sigmoid_f(z0[3]);
                    o[4] = bflo(yy.z) * sigmoid_f(z1[0]); o[5] = bfhi(yy.z) * sigmoid_f(z1[1]); o[6] = bflo(yy.w) * sigmoid_f(z1[2]); o[7] = bfhi(yy.w) * sigmoid_f(z1[3]);
                    u32x4 w; w.x = cvt_pk_bf16(o[0], o[1]); w.y = cvt_pk_bf16(o[2], o[3]); w.z = cvt_pk_bf16(o[4], o[5]); w.w = cvt_pk_bf16(o[6], o[7]);
                    *(u32x4*)(cat + (size_t)t * D + CW + col) = w; }
        }
    }
};
struct EpiRes {
    static constexpr bool PERM = false;
    const float* xi; float* xo; bf16_t* xb;
    __device__ __forceinline__ void operator()(const f32x4 (&acc)[2][2][4][2], const Unit& u, int wr, int wc, int fr, int fq) const {
#pragma unroll
        for (int ai = 0; ai < 2; ++ai)
#pragma unroll
            for (int m = 0; m < 4; ++m) { const size_t row = (size_t)(u.pm * BM + ai * HALF + wr * 64 + m * 16 + fr);
#pragma unroll
                for (int bj = 0; bj < 2; ++bj)
#pragma unroll
                    for (int n = 0; n < 2; ++n) { const int col = u.pn * BM + bj * HALF + wc * 32 + 16 * n + 4 * fq;
                        const f32x4 v = *(const f32x4*)(xi + row * D + col) + acc[ai][bj][m][n];
                        *(f32x4*)(xo + row * D + col) = v;
                        u32x2 w; w.x = cvt_pk_bf16(v[0], v[1]); w.y = cvt_pk_bf16(v[2], v[3]); *(u32x2*)(xb + row * D + col) = w; } }
    }
};


__device__ __forceinline__ void p0_small(Frame& F, const Args& a) {
    bf16_t* wr = (bf16_t*)(F.ws + WS_WR); float* wf = (float*)(F.ws + WS_WF);
    const int gt = (int)blockIdx.x * (NWAVES * 64) + F.tid(), NGT = F.G * NWAVES * 64;
    for (int idx = gt; idx < 2 * 48 * D; idx += NGT) {
        const int layer = idx / (48 * D), rem = idx % (48 * D), n = rem / D, k = rem % D;
        float v = 0.f;
        if (n < 4) v = a.in[20][((size_t)layer * D + k) * 4 + n];
        else if (n < 36) v = a.in[22][((size_t)layer * D + k) * 32 + (n - 4)];
        v *= a.in[19][(size_t)layer * D + k];
        const unsigned hi = cvt_pk_bf16(v, v) & 0xffffu; const float lo = v - bf2f((unsigned short)hi);
        wr[((size_t)(layer * 2 + 0) * 48 + n) * D + k] = (bf16_t)hi;
        wr[((size_t)(layer * 2 + 1) * 48 + n) * D + k] = (bf16_t)(cvt_pk_bf16(lo, lo) & 0xffffu);
    }
    for (int idx = gt; idx < NH * D; idx += NGT) { const int h = idx / D, k = idx % D; wf[idx] = a.in[16][(size_t)k * (3 * D + NH) + 3 * D + h] * a.in[15][k]; }
}

__device__ __forceinline__ void router_phase(Frame& F, const Args& a, int layer) {
    const float* X = (const float*)(F.ws + WS_XA); float* rr = (float*)(F.ws + WS_R);
    const bf16_t* wr = (const bf16_t*)(F.ws + WS_WR) + (size_t)layer * 2 * 48 * D;
    int* cnt = (int*)(F.ctl + CW_CNT) + layer * 64; int* list = (int*)(F.ws + WS_LIST); float* pw = (float*)(F.ws + WS_PW);
    LAS float* P = (LAS float*)F.lds;
    LAS float* SS = P + 2 * 4 * 16 * 48;
    const int lane = F.lane(); const int rt = F.wave >> 2, kq = F.wave & 3, li = lane & 15, kg = lane >> 4;
    for (int item = blockIdx.x; item < T / 32; item += F.G) {
        const int r0 = item * 32 + rt * 16;
        f32x4 acc[3]; acc[0] = acc[1] = acc[2] = (f32x4){0.f, 0.f, 0.f, 0.f};
        float ss = 0.f;
        const float* xp = X + (size_t)(r0 + li) * D + kq * 512 + 8 * kg;
        const bf16_t* wp = wr + (size_t)li * D + kq * 512 + 8 * kg;
#pragma unroll 2
        for (int ks = 0; ks < 16; ++ks) {
            const f32x4 x0 = *(const f32x4*)(xp + ks * 32), x1 = *(const f32x4*)(xp + ks * 32 + 4);
            ss += (x0[0] * x0[0] + x0[1] * x0[1]) + (x0[2] * x0[2] + x0[3] * x0[3]) + (x1[0] * x1[0] + x1[1] * x1[1]) + (x1[2] * x1[2] + x1[3] * x1[3]);
            u32x4 hw; hw.x = cvt_pk_bf16(x0[0], x0[1]); hw.y = cvt_pk_bf16(x0[2], x0[3]); hw.z = cvt_pk_bf16(x1[0], x1[1]); hw.w = cvt_pk_bf16(x1[2], x1[3]);
            u32x4 lw; lw.x = cvt_pk_bf16(x0[0] - bflo(hw.x), x0[1] - bfhi(hw.x)); lw.y = cvt_pk_bf16(x0[2] - bflo(hw.y), x0[3] - bfhi(hw.y));
            lw.z = cvt_pk_bf16(x1[0] - bflo(hw.z), x1[1] - bfhi(hw.z)); lw.w = cvt_pk_bf16(x1[2] - bflo(hw.w), x1[3] - bfhi(hw.w));
            const bf16x8 ah = __builtin_bit_cast(bf16x8, hw), al = __builtin_bit_cast(bf16x8, lw);
#pragma unroll
            for (int ct = 0; ct < 3; ++ct) {
                const bf16x8 bh = *(const bf16x8*)(wp + (size_t)ct * 16 * D + ks * 32);
                const bf16x8 bl = *(const bf16x8*)(wp + (size_t)(48 + ct * 16) * D + ks * 32);
                acc[ct] = __builtin_amdgcn_mfma_f32_16x16x32_bf16(ah, bh, acc[ct], 0, 0, 0);
                acc[ct] = __builtin_amdgcn_mfma_f32_16x16x32_bf16(al, bh, acc[ct], 0, 0, 0);
                acc[ct] = __builtin_amdgcn_mfma_f32_16x16x32_bf16(ah, bl, acc[ct], 0, 0, 0);
            }
        }
        ss += __shfl_xor(ss, 16); ss += __shfl_xor(ss, 32);
        __syncthreads();
#pragma unroll
        for (int ct = 0; ct < 3; ++ct)
#pragma unroll
            for (int rg = 0; rg < 4; ++rg) P[((rt * 4 + kq) * 16 + 4 * kg + rg) * 48 + ct * 16 + li] = acc[ct][rg];
        if (kg == 0) SS[(rt * 4 + kq) * 16 + li] = ss;
        __syncthreads();
        if (kq == 0 && lane < 16) {
            const int row = lane, t = r0 + row;
            float lg[36];
#pragma unroll
            for (int c = 0; c < 36; ++c) lg[c] = (P[((rt * 4 + 0) * 16 + row) * 48 + c] + P[((rt * 4 + 1) * 16 + row) * 48 + c]) + (P[((rt * 4 + 2) * 16 + row) * 48 + c] + P[((rt * 4 + 3) * 16 + row) * 48 + c]);
            const float sq = (SS[(rt * 4 + 0) * 16 + row] + SS[(rt * 4 + 1) * 16 + row]) + (SS[(rt * 4 + 2) * 16 + row] + SS[(rt * 4 + 3) * 16 + row]);
            const float r = rsqrtf(sq * (1.f / D) + EPS);
            rr[t] = r;
            float g4[4];
#pragma unroll
            for (int i = 0; i < 4; ++i) g4[i] = lg[i] * r + a.in[21][layer * 4 + i];
            float gmax = g4[0]; int gi = 0;
#pragma unroll
            for (int i = 1; i < 4; ++i) if (g4[i] > gmax) { gmax = g4[i]; gi = i; }
            float den = 0.f;
#pragma unroll
            for (int i = 0; i < 4; ++i) den += __expf(g4[i] - gmax);
            const float gw = 1.f / den;
            float e8[8];
#pragma unroll
            for (int i = 0; i < 8; ++i) {
                const float v0 = lg[4 + i], v1 = lg[12 + i], v2 = lg[20 + i], v3 = lg[28 + i];
                const float v = gi == 0 ? v0 : (gi == 1 ? v1 : (gi == 2 ? v2 : v3));
                e8[i] = v * r + a.in[23][layer * 32 + gi * 8 + i];
            }
            float v1 = e8[0]; int e1 = 0;
#pragma unroll
            for (int i = 1; i < 8; ++i) if (e8[i] > v1) { v1 = e8[i]; e1 = i; }
            float v2 = -3.0e38f; int e2 = 0;
#pragma unroll
            for (int i = 0; i < 8; ++i) if (i != e1 && e8[i] > v2) { v2 = e8[i]; e2 = i; }
            const float w1 = 1.f / (1.f + __expf(v2 - v1)), w2 = 1.f - w1;
            const int E1 = gi * 8 + e1, E2 = gi * 8 + e2;
            const int p1 = atomicAdd(&cnt[E1], 1); list[E1 * T + p1] = 2 * t;
            const int p2 = atomicAdd(&cnt[E2], 1); list[E2 * T + p2] = 2 * t + 1;
            pw[2 * t] = w1 * gw; pw[2 * t + 1] = w2 * gw;
        }
    }
    __syncthreads();
}

struct MoeOrder {
    const LAS int* tab; const int* list; const char* Abase; const char* Bbase; size_t bexp, bstep, arow2; int nN, G, c; bool gather;
    __device__ __forceinline__ bool next(int i, Unit& u) const {
        const int L = i * G + c; if (L >= __builtin_amdgcn_readfirstlane(tab[32])) return false;
        int E = 0;
        for (int j = 1; j < 32; ++j) E += (__builtin_amdgcn_readfirstlane(tab[j]) <= L) ? 1 : 0;
        const int local = L - __builtin_amdgcn_readfirstlane(tab[E]), mt = local / nN, pn = local % nN, hb = __builtin_amdgcn_readfirstlane(tab[33 + E]), cn = __builtin_amdgcn_readfirstlane(tab[34 + E]) - hb;
        u.e = E; u.pm = mt; u.pn = pn; u.nvalid = (cn - mt * BM) < BM ? (cn - mt * BM) : BM; u.rows = list + (size_t)E * T + mt * BM; u.aux = hb + mt * BM;
        u.A = gather ? Abase : Abase + (size_t)u.aux * arow2; u.B = Bbase + (size_t)E * bexp + (size_t)pn * bstep; return true;
    }
};
__device__ __forceinline__ void moe_tables(Frame& F, int layer, int nN) {
    LAS int* tab = (LAS int*)(F.lds + LDSCTL_OFF);
    __syncthreads();
    if (F.tid() == 0) {
        const int* cnt = (const int*)(F.ctl + CW_CNT) + layer * 64;
        int up = 0, rp = 0;
        for (int e = 0; e < 32; ++e) { const int c = __hip_atomic_load(cnt + e, __ATOMIC_RELAXED, __HIP_MEMORY_SCOPE_AGENT); tab[e] = up; tab[33 + e] = rp; up += ((c + BM - 1) / BM) * nN; rp += c; }
        tab[32] = up; tab[65] = rp;
    }
    __syncthreads();
}
struct EpiM1 {
    static constexpr bool PERM = true;
    const float* rr; bf16_t* H;
    __device__ __forceinline__ void operator()(const f32x4 (&acc)[2][2][4][2], const Unit& u, int wr, int wc, int fr, int fq) const {
        const int col = u.pn * 128 + wc * 32 + 8 * fq;
#pragma unroll
        for (int ai = 0; ai < 2; ++ai)
#pragma unroll
            for (int m = 0; m < 4; ++m) { const int lr = ai * HALF + wr * 64 + m * 16 + fr;
                if (lr < u.nvalid) {
                    const float sc = rr[u.rows[lr] >> 1];
                    float o[8];
#pragma unroll
                    for (int n = 0; n < 2; ++n)
#pragma unroll
                        for (int i = 0; i < 4; ++i) { const float g = acc[ai][0][m][n][i] * sc, up = acc[ai][1][m][n][i] * sc; o[4 * n + i] = g * sigmoid_f(g) * up; }
                    u32x4 w; w.x = cvt_pk_bf16(o[0], o[1]); w.y = cvt_pk_bf16(o[2], o[3]); w.z = cvt_pk_bf16(o[4], o[5]); w.w = cvt_pk_bf16(o[6], o[7]);
                    *(u32x4*)(H + (size_t)(u.aux + lr) * FF + col) = w; } }
    }
};
struct EpiM2 {
    static constexpr bool PERM = true;
    const float* pw; bf16_t* Y;
    __device__ __forceinline__ void operator()(const f32x4 (&acc)[2][2][4][2], const Unit& u, int wr, int wc, int fr, int fq) const {
#pragma unroll
        for (int ai = 0; ai < 2; ++ai)
#pragma unroll
            for (int m = 0; m < 4; ++m) { const int lr = ai * HALF + wr * 64 + m * 16 + fr;
                if (lr < u.nvalid) {
                    const int p = u.rows[lr]; const float w8 = pw[p];
#pragma unroll
                    for (int bj = 0; bj < 2; ++bj) { const f32x4 v0 = acc[ai][bj][m][0] * w8, v1 = acc[ai][bj][m][1] * w8;
                        u32x4 w; w.x = cvt_pk_bf16(v0[0], v0[1]); w.y = cvt_pk_bf16(v0[2], v0[3]); w.z = cvt_pk_bf16(v1[0], v1[1]); w.w = cvt_pk_bf16(v1[2], v1[3]);
                        *(u32x4*)(Y + (size_t)p * D + u.pn * BM + bj * HALF + wc * 32 + 8 * fq) = w; } } }
    }
};
__device__ __forceinline__ void moe_gemms_m1(Frame& F, const Args& a, int layer) {
    moe_tables(F, layer, 4);
    MoeOrder S; S.tab = (const LAS int*)(F.lds + LDSCTL_OFF); S.list = (const int*)(F.ws + WS_LIST); S.Abase = (const char*)(F.ws + WS_XB);
    S.Bbase = (const char*)(F.ws + WS_WGU) + (size_t)layer * NE * 1024 * D * 2; S.bexp = (size_t)1024 * D * 2; S.bstep = (size_t)BM * D * 2; S.arow2 = 0; S.nN = 4; S.G = F.G; S.c = (int)blockIdx.x; S.gather = true;
    EpiM1 E{(const float*)(F.ws + WS_R), (bf16_t*)(F.ws + WS_H)};
    gemm_phase<AGather, EpiM1, MoeOrder, false, true>(F.lds, F.wave, D, AGather{D * 2}, S, E);
    if (layer == 0) { const int tot = __builtin_amdgcn_readfirstlane(S.tab[32]), c = (int)blockIdx.x; phase_done(F, 8, c < tot ? (tot - c + F.G - 1) / F.G : 0); if (FILLMASK & 2) filler(F, a, F.ctl + CW_DONE + 64 * 8, (unsigned)tot); }
}
__device__ __forceinline__ void moe_gemms_m2(Frame& F, const Args& a, int layer) {
    moe_tables(F, layer, 8);
    MoeOrder S; S.tab = (const LAS int*)(F.lds + LDSCTL_OFF); S.list = (const int*)(F.ws + WS_LIST); S.Abase = (const char*)(F.ws + WS_H);
    S.Bbase = (const char*)(F.ws + WS_WD) + (size_t)layer * NE * D * FF * 2; S.bexp = (size_t)D * FF * 2; S.bstep = (size_t)BM * FF * 2; S.arow2 = (size_t)FF * 2; S.nN = 8; S.G = F.G; S.c = (int)blockIdx.x; S.gather = false;
    EpiM2 E{(const float*)(F.ws + WS_PW), (bf16_t*)(F.ws + WS_Y)};
    gemm_phase<ARow, EpiM2, MoeOrder, false, true>(F.lds, F.wave, FF, ARow{FF * 2}, S, E);
    if (layer == 0) { const int tot = __builtin_amdgcn_readfirstlane(S.tab[32]), c = (int)blockIdx.x; phase_done(F, 9, c < tot ? (tot - c + F.G - 1) / F.G : 0); if (FILLMASK & 2) filler(F, a, F.ctl + CW_DONE + 64 * 9, (unsigned)tot); }
}

template <int MODE>
__device__ __forceinline__ void combine_phase(Frame& F, const Args& a) {
    const int lane = F.lane();
    const float* X = (const float*)(F.ws + WS_XA); const bf16_t* Y = (const bf16_t*)(F.ws + WS_Y);
    const int gw = F.vcu * NWAVES + F.wave, NGW = F.G * NWAVES;
    LAS float* wfl = (LAS float*)F.lds;
    if (MODE == 0) {
        const float* wf = (const float*)(F.ws + WS_WF);
        for (int i = F.tid(); i < NH * D / 4; i += NWAVES * 64) *(LAS f32x4*)(wfl + 4 * i) = *(const f32x4*)(wf + 4 * i);
        __syncthreads();
    }
    for (int t = gw; t < T; t += NGW) {
        const f32x4* xr = (const f32x4*)(X + (size_t)t * D) + lane;
        const u32x2* y0 = (const u32x2*)(Y + (size_t)(2 * t) * D) + lane; const u32x2* y1 = (const u32x2*)(Y + (size_t)(2 * t + 1) * D) + lane;
        f32x4 v[8]; float s = 0.f;
#pragma unroll
        for (int j = 0; j < 8; ++j) { const f32x4 x = xr[64 * j]; const u32x2 p = y0[64 * j], q = y1[64 * j];
            v[j][0] = x[0] + (bflo(p.x) + bflo(q.x)); v[j][1] = x[1] + (bfhi(p.x) + bfhi(q.x)); v[j][2] = x[2] + (bflo(p.y) + bflo(q.y)); v[j][3] = x[3] + (bfhi(p.y) + bfhi(q.y));
            s += (v[j][0] * v[j][0] + v[j][1] * v[j][1]) + (v[j][2] * v[j][2] + v[j][3] * v[j][3]); }
        s = wave_sum(s);
        const float r = rsqrtf(s * (1.f / D) + EPS);
        if (MODE == 0) {
            f32x4* xo = (f32x4*)((float*)(F.ws + WS_XBB) + (size_t)t * D) + lane; u32x2* xb = (u32x2*)((bf16_t*)(F.ws + WS_XB) + (size_t)t * D) + lane;
#pragma unroll
            for (int j = 0; j < 8; ++j) { xo[64 * j] = v[j]; u32x2 w; w.x = cvt_pk_bf16(v[j][0], v[j][1]); w.y = cvt_pk_bf16(v[j][2], v[j][3]); xb[64 * j] = w; }
            if (lane == 0) ((float*)(F.ws + WS_R))[t] = r;
            float myf = 0.f;
#pragma unroll
            for (int h = 0; h < NH; ++h) {
                float d = 0.f;
#pragma unroll
                for (int j = 0; j < 8; ++j) { const f32x4 w = *(const LAS f32x4*)(wfl + h * D + 256 * j + 4 * lane); d += (v[j][0] * w[0] + v[j][1] * w[1]) + (v[j][2] * w[2] + v[j][3] * w[3]); }
                d = wave_sum(d);
                if (lane == h) myf = d;
            }
            if (lane < NH) { const float z = myf * r + a.in[17][lane]; ((float*)(F.ws + WS_LOGF))[(size_t)t * NH + lane] = fminf(z, 0.f) - log1pf(__expf(-fabsf(z))); }
        } else {
            const f32x4* gp = (const f32x4*)a.in[27] + lane; f32x4* op = (f32x4*)(a.out + (size_t)t * D) + lane;
#pragma unroll
            for (int j = 0; j < 8; ++j) { const f32x4 g = gp[64 * j]; op[64 * j] = v[j] * r * g; }
        }
    }
    if (MODE == 0) __syncthreads();
}


namespace att {
constexpr int AD = 128;
constexpr float SCALE = 0.08838834764831845f;
constexpr float THR = 8.f;
constexpr int NW = 8, QBLK = 32, KVBLK = 64, QB = NW * QBLK;
constexpr int SHM_V = KVBLK * AD * 2, SHM_K = KVBLK * AD * 2;
constexpr int CK_OFF = 2 * SHM_V + 2 * SHM_K + NW * 64 * 4;
constexpr int OST = 2048;
#define KSWZ(row, colB) ((row) * 256 + ((colB) ^ (((row) & 7) << 4)))
#define SBAR() __builtin_amdgcn_sched_barrier(0)
__device__ __forceinline__ int v_st(int k, int c) { const int kk = (k & ~0xC) | ((k & 4) << 1) | ((k & 8) >> 1); return ((kk >> 3) * 4 + (c >> 5)) * 512 + ((kk & 7) * 32 + (c & 31)) * 2; }
__device__ __forceinline__ int v_rd_base(int lane) { return ((lane & 3) << 3) | (((lane >> 2) & 3) << 6) | (((lane >> 4) & 1) << 5) | (((lane >> 5) & 1) << 8); }
constexpr int v_rd_off(int d0, int ks, int half) { return d0 * 512 + ks * 4096 + half * 2048; }
__device__ __forceinline__ int crow(int r, int hi) { return (r & 3) + 8 * (r >> 2) + 4 * hi; }
__device__ __forceinline__ unsigned cvtpk(float lo, float hi) { unsigned r; asm volatile("v_cvt_pk_bf16_f32 %0, %1, %2" : "=v"(r) : "v"(lo), "v"(hi)); return r; }
__device__ __forceinline__ bf16x8 load8(const bf16_t* p) { return *reinterpret_cast<const bf16x8*>(p); }
__device__ __forceinline__ void mask_tile(f32x16& p0, f32x16& p1, int dq) {
    const float NEG = -__builtin_inff();
#pragma unroll
    for (int r = 0; r < 16; ++r) {
        const int c = (r & 3) + 8 * (r >> 2);
        if (dq - c < 0) p0[r] = NEG;
        if (dq - c - 32 < 0) p1[r] = NEG;
    }
}
__device__ __forceinline__ void partialSM(f32x16& p0, f32x16& p1, float& m_reg, float& mn, float& alpha) {
    float pmax = p0[0];
#pragma unroll
    for (int r = 1; r < 16; ++r) pmax = fmaxf(pmax, p0[r]);
#pragma unroll
    for (int r = 0; r < 16; ++r) pmax = fmaxf(pmax, p1[r]);
    { auto rr = __builtin_amdgcn_permlane32_swap(__float_as_uint(pmax), __float_as_uint(pmax), false, false);
      pmax = fmaxf(__uint_as_float(rr[0]), __uint_as_float(rr[1])); }
    constexpr float C2 = 1.4426950408889634f * SCALE;
    if (__builtin_expect(__all((pmax - m_reg) * SCALE <= THR), 1)) { mn = m_reg; alpha = 1.f; }
    else { mn = fmaxf(m_reg, pmax); alpha = __builtin_amdgcn_exp2f((m_reg - mn) * C2); m_reg = mn; }
    const float mnL = -mn * C2;
#pragma unroll
    for (int r = 0; r < 16; ++r) p0[r] = fmaf(p0[r], C2, mnL);
#pragma unroll
    for (int r = 0; r < 16; ++r) p1[r] = fmaf(p1[r], C2, mnL);
#pragma unroll
    for (int r = 0; r < 16; ++r) p0[r] = __builtin_amdgcn_exp2f(p0[r]);
}
__device__ __forceinline__ void finishSM(f32x16& p0, f32x16& p1, float alpha, float& l_reg, bf16x8& pa0, bf16x8& pa1, bf16x8& pa2, bf16x8& pa3) {
#pragma unroll
    for (int r = 0; r < 16; ++r) p1[r] = __builtin_amdgcn_exp2f(p1[r]);
    float ps = 0;
#pragma unroll
    for (int r = 0; r < 16; ++r) ps += p0[r];
#pragma unroll
    for (int r = 0; r < 16; ++r) ps += p1[r];
    { auto rr = __builtin_amdgcn_permlane32_swap(__float_as_uint(ps), __float_as_uint(ps), false, false);
      ps = __uint_as_float(rr[0]) + __uint_as_float(rr[1]); }
    l_reg = l_reg * alpha + ps;
#define PK4(P, B_, OUT) do { unsigned a0 = cvtpk(P[B_+0], P[B_+1]), a1 = cvtpk(P[B_+2], P[B_+3]);                          \
        unsigned b0 = cvtpk(P[B_+4], P[B_+5]), b1 = cvtpk(P[B_+6], P[B_+7]);                                             \
        auto r0 = __builtin_amdgcn_permlane32_swap(a0, b0, false, false); auto r1 = __builtin_amdgcn_permlane32_swap(a1, b1, false, false); \
        u32x4 w = {r0[0], r1[0], r0[1], r1[1]}; OUT = *reinterpret_cast<bf16x8*>(&w); } while (0)
    PK4(p0, 0, pa0); PK4(p0, 8, pa1); PK4(p1, 0, pa2); PK4(p1, 8, pa3);
#undef PK4
}
template <int KB>
__device__ __forceinline__ void qkt(f32x16& p0, f32x16& p1, const char* K_lds, int r32, int hi, const bf16x8* qr, const float* ckt, float cq) {
#pragma unroll
    for (int q = 0; q < 4; ++q) {
        const f32x4 c0 = *(const f32x4*)(ckt + 8 * q + 4 * hi), c1 = *(const f32x4*)(ckt + 32 + 8 * q + 4 * hi);
#pragma unroll
        for (int i = 0; i < 4; ++i) { p0[4 * q + i] = cq - c0[i]; p1[4 * q + i] = cq - c1[i]; }
    }
    const char* kb[4];
#pragma unroll
    for (int dd = 0; dd < 4; ++dd) kb[dd] = K_lds + KB * SHM_K + KSWZ(r32, (dd * 16 + hi * 8) * 2);
#pragma unroll
    for (int d0 = 0; d0 < 8; ++d0) { const char* a = kb[d0 & 3] + (d0 >> 2) * 128;
        bf16x8 b0 = *reinterpret_cast<const bf16x8*>(a);
        bf16x8 b1 = *reinterpret_cast<const bf16x8*>(a + 32 * 256);
        p0 = __builtin_amdgcn_mfma_f32_32x32x16_bf16(b0, qr[d0], p0, 0, 0, 0);
        p1 = __builtin_amdgcn_mfma_f32_32x32x16_bf16(b1, qr[d0], p1, 0, 0, 0); }
}
template <int VB>
__device__ __forceinline__ void pv_tile(f32x16* o, int vb0, bf16x8 pa0, bf16x8 pa1, bf16x8 pa2, bf16x8 pa3) {
#define TRRD(dst, off) asm volatile("ds_read_b64_tr_b16 %0, %1 offset:%2" : "=&v"(dst) : "v"(vb0), "i"(off) : "memory")
#define PV_D0(d0) do { s16x4 l0, l1, l2, l3, h0, h1, h2, h3; constexpr int b_ = VB * SHM_V + v_rd_off(d0, 0, 0); \
        TRRD(l0, b_); TRRD(h0, b_ + 2048); TRRD(l1, b_ + 4096); TRRD(h1, b_ + 6144); TRRD(l2, b_ + 8192); TRRD(h2, b_ + 10240); TRRD(l3, b_ + 12288); TRRD(h3, b_ + 14336); \
        asm volatile("s_waitcnt lgkmcnt(0)" ::: "memory"); SBAR();   \
        o[d0] = __builtin_amdgcn_mfma_f32_32x32x16_bf16(pa0, (bf16x8){l0[0], l0[1], l0[2], l0[3], h0[0], h0[1], h0[2], h0[3]}, o[d0], 0, 0, 0);   \
        o[d0] = __builtin_amdgcn_mfma_f32_32x32x16_bf16(pa1, (bf16x8){l1[0], l1[1], l1[2], l1[3], h1[0], h1[1], h1[2], h1[3]}, o[d0], 0, 0, 0);   \
        o[d0] = __builtin_amdgcn_mfma_f32_32x32x16_bf16(pa2, (bf16x8){l2[0], l2[1], l2[2], l2[3], h2[0], h2[1], h2[2], h2[3]}, o[d0], 0, 0, 0);   \
        o[d0] = __builtin_amdgcn_mfma_f32_32x32x16_bf16(pa3, (bf16x8){l3[0], l3[1], l3[2], l3[3], h3[0], h3[1], h3[2], h3[3]}, o[d0], 0, 0, 0); } while (0)
    PV_D0(0); PV_D0(1); PV_D0(2); PV_D0(3);
#undef PV_D0
#undef TRRD
}
struct Bases { const bf16_t* Q; const bf16_t* K; const bf16_t* V; bf16_t* O; const float* ck; const float* kn2; };
struct BlockRef { int h, qb;
    __device__ __forceinline__ int P0() const { return qb * QB; }
    __device__ __forceinline__ const bf16_t* Q(const Bases& b) const { return b.Q + ((size_t)h * T + (size_t)qb * QB) * AD; }
    __device__ __forceinline__ const bf16_t* K(const Bases& b) const { return b.K + (size_t)h * T * AD; }
    __device__ __forceinline__ const bf16_t* V(const Bases& b) const { return b.V + (size_t)h * T * AD; }
    __device__ __forceinline__ bf16_t* O(const Bases& b) const { return b.O + (size_t)qb * QB * OST + h * AD; }
    __device__ __forceinline__ const float* ck(const Bases& b) const { return b.ck + (size_t)h * T; }
    __device__ __forceinline__ const float* kn2(const Bases& b) const { return b.kn2 + (size_t)h * T; } };
struct Seam { bf16x8 qr[8]; bf16x8 st_v0, st_v1, st_k0, st_k1; };
constexpr float TH_RAW = 28.f * 11.313708498984761f;
#define ROW(p, k0, rr) ((p) + (size_t)((k0) + (rr)) * AD + sc)
#define VMW() asm volatile("s_waitcnt vmcnt(0)" ::: "memory")
#define VMWN(n) asm volatile("s_waitcnt vmcnt(%0)" :: "i"(n) : "memory")
#define SLOAD_H(Kp, Vp, k0) do { S.st_v0 = load8(ROW(Vp, k0, sr)); S.st_v1 = load8(ROW(Vp, k0, 32 + sr));              \
                         S.st_k0 = load8(ROW(Kp, k0, sr)); S.st_k1 = load8(ROW(Kp, k0, 32 + sr)); } while (0)
#define SWRITE_HK(bf) do { *(bf16x8*)(K_lds + (bf) * SHM_K + kws) = S.st_k0; *(bf16x8*)(K_lds + (bf) * SHM_K + kws + 32 * 256) = S.st_k1; } while (0)
#define SWRITE_HV(bf) do { *(bf16x8*)(V_lds + (bf) * SHM_V + vst0) = S.st_v0; *(bf16x8*)(V_lds + (bf) * SHM_V + vst1) = S.st_v1; } while (0)
#define SWRITE_H(bf) do { SWRITE_HV(bf); SWRITE_HK(bf); } while (0)
__device__ __forceinline__ void fox_prime(const Bases& bs, const BlockRef& cur, char* lds, Seam& S, const int wid) {
    int tid = wid * 64 + lane_id(); asm volatile("" : "+v"(tid));
    const int lane = tid & 63, r32 = lane & 31, hi = lane >> 5;
    const int sr = tid >> 4, sc = (tid & 15) * 8, kws = KSWZ(sr, sc * 2); char* K_lds = lds + 2 * SHM_V;
#pragma unroll
    for (int d0 = 0; d0 < 8; ++d0) S.qr[d0] = load8(cur.Q(bs) + (size_t)(wid * QBLK + r32) * AD + d0 * 16 + hi * 8);
    SLOAD_H(cur.K(bs), cur.V(bs), cur.P0() + QB - KVBLK); VMW(); SWRITE_HK(0);
    __syncthreads();
}
__device__ __forceinline__ void fox_block(const Bases& bs, const BlockRef& cur, const BlockRef& nxt, char* lds, Seam& S, const int wid) {
    int tid = wid * 64 + lane_id(); asm volatile("" : "+v"(tid));
    const int lane = tid & 63, r32 = lane & 31, hi = lane >> 5;
    const int P0 = cur.P0(); const int NT0 = (P0 + QB - 1) / KVBLK + 1;
    int NT = NT0;
    const int qlo = P0 + wid * QBLK, qm = qlo + r32 - 4 * hi;
    char* V_lds = lds; char* K_lds = lds + 2 * SHM_V;
    float* ws = (float*)(lds + 2 * SHM_V + 2 * SHM_K) + wid * 64; float* li_l = ws, * al_l = ws + 32;
    float* wsall = (float*)(lds + 2 * SHM_V + 2 * SHM_K);
    float* ckl = (float*)(lds + CK_OFF);
    float kmax2 = 0.f;
    { const int nq = (P0 + QB) >> 2; const float* ckg = cur.ck(bs); const float* kng = cur.kn2(bs); for (int i = tid; i < nq; i += NW * 64) { *(f32x4*)(ckl + 4 * i) = *(const f32x4*)(ckg + 4 * i);
          const f32x4 kn = *(const f32x4*)(kng + 4 * i); kmax2 = fmaxf(fmaxf(kmax2, fmaxf(kn[0], kn[1])), fmaxf(kn[2], kn[3])); } }
#pragma unroll
    for (int o_ = 1; o_ < 64; o_ <<= 1) kmax2 = fmaxf(kmax2, __shfl_xor(kmax2, o_));
    if (lane == 0) li_l[1] = kmax2;
    __syncthreads();
    {   float km = wsall[1];
#pragma unroll
        for (int w_ = 1; w_ < NW; ++w_) km = fmaxf(km, wsall[w_ * 64 + 1]);
        kmax2 = km; }
    const float cq = ckl[qlo + r32];
    float qn2 = 0.f;
#pragma unroll
    for (int d0 = 0; d0 < 8; ++d0) {
#pragma unroll
        for (int e = 0; e < 8; ++e) { const float qv = __uint_as_float(((unsigned)(unsigned short)S.qr[d0][e]) << 16); qn2 += qv * qv; } }
    { auto rr = __builtin_amdgcn_permlane32_swap(__float_as_uint(qn2), __float_as_uint(qn2), false, false); qn2 = __uint_as_float(rr[0]) + __uint_as_float(rr[1]); }
    const float needc = __builtin_sqrtf(qn2 * kmax2) * 1.02f + cq + TH_RAW;
    float m_reg = -1e30f, l_reg = 0; f32x16 o[4] = {};
    const int sr = tid >> 4, sc = (tid & 15) * 8, vst0 = v_st(sr, sc), vst1 = v_st(32 + sr, sc), kws = KSWZ(sr, sc * 2);
    const int vb0 = (int)(uintptr_t)V_lds + v_rd_base(lane);
    const bf16_t* Kh = cur.K(bs); const bf16_t* Vh = cur.V(bs);
#define RESC(a) do { if (__any((a) < 1.f)) { if (hi == 0) al_l[r32] = (a); asm volatile("s_waitcnt lgkmcnt(0)" ::: "memory");              \
                     for (int d_ = 0; d_ < 4; ++d_) for (int r = 0; r < 16; ++r) o[d_][r] *= al_l[crow(r, hi)]; } } while (0)
#define KBASE(t) ((NT0 - 1 - (t)) * KVBLK)
#define MASKT(P0_, P1_, t) do { const int kb_ = KBASE(t); if (kb_ + KVBLK - 1 > qlo) mask_tile(P0_, P1_, qm - kb_); } while (0)
    constexpr int NQL = 8;
#define SEAM_K0() do { VMWN(NQL); SWRITE_HK(0); SBAR(); } while (0)
    f32x16 pA0, pA1, pB0, pB1; float mnA, mnB, alA, alB; bf16x8 pa0, pa1, pa2, pa3;
    SWRITE_HV(0); SBAR();
    if (NT > 1) { SLOAD_H(Kh, Vh, KBASE(1)); }
    SBAR(); qkt<0>(pA0, pA1, K_lds, r32, hi, S.qr, ckl + KBASE(0), cq);
    MASKT(pA0, pA1, 0); partialSM(pA0, pA1, m_reg, mnA, alA);
    if (NT > 1) { VMW(); SWRITE_H(1); }
    __syncthreads();
#define HALF_STEP(PX0, PX1, mnX, alX, PY0, PY1, alY, t, KB, VB, SB) do {                                                      \
        SBAR(); qkt<KB>(PX0, PX1, K_lds, r32, hi, S.qr, ckl + KBASE(t), cq);                                                   \
        finishSM(PY0, PY1, alY, l_reg, pa0, pa1, pa2, pa3); SBAR();                                                           \
        if ((t) + 1 < NT) { SLOAD_H(Kh, Vh, KBASE((t) + 1)); SBAR(); }                                                        \
        pv_tile<VB>(o, vb0, pa0, pa1, pa2, pa3); MASKT(PX0, PX1, (t)); partialSM(PX0, PX1, m_reg, mnX, alX);                   \
        __syncthreads();                                                                                                      \
        if ((t) + 1 < NT) { VMW(); SWRITE_H(SB); }                                                                            \
        RESC(alX); __syncthreads(); } while (0)
    for (int t = 1; t + 1 < NT; t += 2) {
        HALF_STEP(pB0, pB1, mnB, alB, pA0, pA1, alA, t, 1, 0, 0);
        if (t == 3) {
            {   float need = needc - m_reg;
#pragma unroll
                for (int o_ = 1; o_ < 64; o_ <<= 1) need = fmaxf(need, __shfl_xor(need, o_));
                if (lane == 0) li_l[0] = need; }
            __syncthreads();
            {   float need = wsall[0];
#pragma unroll
                for (int w_ = 1; w_ < NW; ++w_) need = fmaxf(need, wsall[w_ * 64]);
                int jstop = NT0;
                for (int jb = 0; jb < NT0; jb += 64) { const int jt = jb + lane; const bool nd = (jt < NT0) && (ckl[jt * KVBLK + KVBLK - 1] < need);
                    const unsigned long long bm = __ballot(nd); if (bm) { jstop = jb + (int)__builtin_ctzll(bm); break; } }
                int nt_eff = NT0 - jstop; if (nt_eff < 5) nt_eff = 5; if (nt_eff < NT) NT = nt_eff; }
        }
        HALF_STEP(pA0, pA1, mnA, alA, pB0, pB1, alB, t + 1, 0, 1, 1);
    }
    const bool even = (NT & 1) == 0;
    if (even) { SBAR(); qkt<1>(pB0, pB1, K_lds, r32, hi, S.qr, ckl + KBASE(NT - 1), cq); SBAR(); }
    SLOAD_H(nxt.K(bs), nxt.V(bs), nxt.P0() + QB - KVBLK); SBAR();
#pragma unroll
    for (int d0 = 0; d0 < 8; ++d0) S.qr[d0] = load8(nxt.Q(bs) + (size_t)(wid * QBLK + r32) * AD + d0 * 16 + hi * 8);
    SBAR();
    finishSM(pA0, pA1, alA, l_reg, pa0, pa1, pa2, pa3); SBAR();
    pv_tile<0>(o, vb0, pa0, pa1, pa2, pa3);
    if (even) { MASKT(pB0, pB1, NT - 1); partialSM(pB0, pB1, m_reg, mnB, alB); __syncthreads(); RESC(alB);
        finishSM(pB0, pB1, alB, l_reg, pa0, pa1, pa2, pa3); SBAR(); pv_tile<1>(o, vb0, pa0, pa1, pa2, pa3); }
    SBAR(); SEAM_K0();
    if (hi == 0) li_l[r32] = l_reg; asm volatile("s_waitcnt lgkmcnt(0)" ::: "memory");
    float rli[16];
#pragma unroll
    for (int r = 0; r < 16; ++r) rli[r] = __builtin_amdgcn_rcpf(li_l[crow(r, hi)]);
    bf16_t* Ow = cur.O(bs) + (size_t)(wid * QBLK) * OST;
#pragma unroll
    for (int r = 0; r < 16; ++r) { const int orow = crow(r, hi);
#pragma unroll
        for (int d0 = 0; d0 < 4; ++d0) { const float v = o[d0][r] * rli[r];
            const float vn = __shfl_xor(v, 1);
            if ((r32 & 1) == 0) *(unsigned*)(Ow + (size_t)orow * OST + d0 * 32 + r32) = cvtpk(v, vn); } }
    __syncthreads();
#undef RESC
#undef KBASE
#undef MASKT
#undef SEAM_K0
#undef HALF_STEP
}
#undef ROW
#undef VMW
#undef VMWN
#undef SLOAD_H
#undef SWRITE_HK
#undef SWRITE_HV
#undef SWRITE_H
}

__device__ __forceinline__ void attn_phase(Frame& F, const Args& a, unsigned char* lds_generic) {
    const bf16_t* Qb = (const bf16_t*)(F.ws + WS_QKV); const bf16_t* Kb = Qb + (size_t)NH * T * DH; const bf16_t* Vb = Kb + (size_t)NH * T * DH;
    bf16_t* Ob = (bf16_t*)(F.ws + WS_CAT); const float* cks = (const float*)(F.ws + WS_CKS); const float* kn2 = (const float*)(F.ctl + CW_KN2);
    constexpr int NQB = T / att::QB, NITEM = NH * NQB;
    unsigned* qhead = F.ctl + CW_QUEUE;
    char* lds = (char*)lds_generic;
    volatile LAS int* slot = (volatile LAS int*)(F.lds + LDSCTL_OFF);
    att::Seam S;
    att::Bases bs; bs.Q = Qb; bs.K = Kb; bs.V = Vb; bs.O = Ob; bs.ck = cks; bs.kn2 = kn2;
#define ATT_REF(R, idx) do { R.qb = NQB - 1 - ((idx) >> 4); R.h = (idx) & 15; } while (0)
    __syncthreads();
    if (F.tid() == 0) { slot[0] = (int)__hip_atomic_fetch_add(qhead, 1u, __ATOMIC_RELAXED, __HIP_MEMORY_SCOPE_AGENT); slot[1] = (int)__hip_atomic_fetch_add(qhead, 1u, __ATOMIC_RELAXED, __HIP_MEMORY_SCOPE_AGENT); }
    __syncthreads();
    int ci = __builtin_amdgcn_readfirstlane(slot[0]), ni = __builtin_amdgcn_readfirstlane(slot[1]);
    if (ci < NITEM) {
        att::BlockRef cur; ATT_REF(cur, ci);
        att::fox_prime(bs, cur, lds, S, F.wave);
        for (;;) {
            att::BlockRef nxt = cur; if (ni < NITEM) ATT_REF(nxt, ni);
            __syncthreads();
            if (F.tid() == 0 && ni < NITEM) slot[0] = (int)__hip_atomic_fetch_add(qhead, 1u, __ATOMIC_RELAXED, __HIP_MEMORY_SCOPE_AGENT);
            att::fox_block(bs, cur, nxt, lds, S, F.wave);
            phase_done(F, 12, 1);
            if (ni >= NITEM) break;
            const int n2 = __builtin_amdgcn_readfirstlane(slot[0]);
            cur = nxt; ci = ni; ni = n2;
        }
    }
#undef ATT_REF
    asm volatile("s_waitcnt vmcnt(0)" ::: "memory");
    __syncthreads();
    if (FILLMASK & 4) filler(F, a, F.ctl + CW_DONE + 64 * 12, NITEM);
}

struct EpiG4 {
    static constexpr bool PERM = true;
    bf16_t* qkv; const float* rr; float* kn2;
    __device__ __forceinline__ void operator()(const f32x4 (&acc)[2][2][4][2], const Unit& u, int wr, int wc, int fr, int fq) const {
#pragma unroll
        for (int ai = 0; ai < 2; ++ai)
#pragma unroll
            for (int m = 0; m < 4; ++m) { const int row = u.pm * BM + ai * HALF + wr * 64 + m * 16 + fr; const float sc = rr[row];
#pragma unroll
                for (int bj = 0; bj < 2; ++bj) { const int col = u.pn * BM + bj * HALF + wc * 32 + 8 * fq, which = col >> 11, hd = (col >> 7) & 15, d = col & 127;
                    const f32x4 v0 = acc[ai][bj][m][0] * sc, v1 = acc[ai][bj][m][1] * sc;
                    u32x4 w; w.x = cvt_pk_bf16(v0[0], v0[1]); w.y = cvt_pk_bf16(v0[2], v0[3]); w.z = cvt_pk_bf16(v1[0], v1[1]); w.w = cvt_pk_bf16(v1[2], v1[3]);
                    *(u32x4*)(qkv + ((size_t)(which * NH + hd) * T + row) * DH + d) = w;
                    if (which == 1) {
                        float ss = (v0[0] * v0[0] + v0[1] * v0[1]) + (v0[2] * v0[2] + v0[3] * v0[3]) + (v1[0] * v1[0] + v1[1] * v1[1]) + (v1[2] * v1[2] + v1[3] * v1[3]);
                        ss += __shfl_xor(ss, 16); ss += __shfl_xor(ss, 32);
                        if (fq == 0) atomicAdd(kn2 + (size_t)hd * T + row, ss); } } }
    }
};
__device__ __forceinline__ void cumsum_phase(Frame& F) {
    if (blockIdx.x >= NH) return;
    const int h = blockIdx.x; const float* logf = (const float*)(F.ws + WS_LOGF); float* cks = (float*)(F.ws + WS_CKS) + (size_t)h * T;
    LAS float* wt = (LAS float*)F.lds;
    float v[16]; float s = 0.f;
#pragma unroll
    for (int i = 0; i < 16; ++i) { s += logf[(size_t)(F.tid() * 16 + i) * NH + h]; v[i] = s; }
    float inc = s;
#pragma unroll
    for (int o = 1; o < 64; o <<= 1) { const float y = __shfl_up(inc, o); if (F.lane() >= o) inc += y; }
    if (F.lane() == 63) wt[F.wave] = inc;
    __syncthreads();
    float base = inc - s;
    for (int w = 0; w < F.wave; ++w) base += wt[w];
    const float k = 11.313708498984761f;
#pragma unroll
    for (int i = 0; i < 16; i += 4) *(f32x4*)(cks + F.tid() * 16 + i) = (f32x4){(base + v[i]) * k, (base + v[i + 1]) * k, (base + v[i + 2]) * k, (base + v[i + 3]) * k};
    __syncthreads();
}

__global__ void __launch_bounds__(NWAVES * 64, 2) mk_fwd(Args args) {
    extern __shared__ __attribute__((aligned(16))) unsigned char lds_raw[];
    Frame F;
    F.lds = (LAS unsigned char*)lds_raw;
    F.MISC = (volatile LAS unsigned*)(F.lds + MISC_OFF);
    F.wave = __builtin_amdgcn_readfirstlane((int)threadIdx.x >> 6);
    F.G = gridDim.x; { const int bx = blockIdx.x; F.vcu = (F.G % 8 == 0) ? (bx % 8) * (F.G / 8) + bx / 8 : bx; }
    F.ws = args.ws; F.ctl = (unsigned*)(args.ws + WS_CTL);
    for (int u = F.tid(); u < (LDS_BYTES - LDSCTL_OFF) / 4; u += NWAVES * 64) ((LAS unsigned*)(F.lds + LDSCTL_OFF))[u] = 0u;
    __syncthreads();
    XcdBarrier bar = xcd_barrier_post(F.ctl + CW_BAR + args.li * XCD_BAR_WORDS, F.MISC + 8, F.tid());
    const int lo = args.ph_lo, hi = args.ph_hi;
#ifdef MK_ONLY
#define IN(k) ((k) == MK_ONLY && lo <= (k) && (k) < hi)
#else
#define IN(k) (lo <= (k) && (k) < hi)
#endif
#define BOTH(k) (IN(k) && IN((k) + 1))
#define GRID_BAR() xcd_barrier(bar, F.tid())

#ifndef DUPMASK
#define DUPMASK 0
#endif
#define PHASE(k, ...) if (IN(k)) { __VA_ARGS__; if ((DUPMASK >> (k)) & 1) { GRID_BAR(); __VA_ARGS__; } if (BOTH(k)) GRID_BAR(); }
    PHASE(0, { if (args.flags & PF_S5) p0_s5_tables(F, args); p0_small(F, args); p0_weights(F, args); p0_rows(F, args.in[0]); })
    PHASE(1, {
        DenseOrder S; S.init(F.ws + WS_XB, (size_t)BM * D * 2, F.ws + WS_WIN0, (size_t)BM * D * 2, T, 4096, F.G, (int)blockIdx.x);
        EpiG1 E{(bf16_t*)(F.ws + WS_PROJ), (bf16_t*)(F.ws + WS_S5A), (const float*)(F.ws + WS_R)};
        gemm_phase<ARow, EpiG1, DenseOrder, true, false>(F.lds, F.wave, D, ARow{D * 2}, S, E); })
    PHASE(2, {
        BatchOrder S; S.A = (const char*)(F.ws + WS_S5A); S.B = (const char*)(F.ws + WS_MB); S.abatch = (size_t)NC * S5K * 2; S.bbatch = (size_t)256 * 512 * 2; S.bstep = 0;
        S.nN = 1; S.nwg = SG; S.G = F.G; S.c = (int)blockIdx.x;
        EpiS1 E{(float*)(F.ws + WS_S)};
        gemm_phase<ARow, EpiS1, BatchOrder, false, false>(F.lds, F.wave, LC * SH, ARow{S5K * 2}, S, E);
 })
    PHASE(3, { s5_scan(F); })
    PHASE(4, {
        BatchOrder S; S.A = (const char*)(F.ws + WS_S5A); S.B = (const char*)(F.ws + WS_TZ); S.abatch = (size_t)NC * S5K * 2; S.bbatch = (size_t)512 * S5K * 2; S.bstep = (size_t)256 * S5K * 2;
        S.nN = 2; S.nwg = SG * 2; S.G = F.G; S.c = (int)blockIdx.x;
        EpiS3 E{(const bf16_t*)(F.ws + WS_S5A), args.in[11], (bf16_t*)(F.ws + WS_YG)};
        gemm_phase<ARow, EpiS3, BatchOrder, false, false>(F.lds, F.wave, S5K, ARow{S5K * 2}, S, E);
        if (F.G > 128) conv_phase(F, args, 128, F.G - 128); else conv_phase(F, args, 0, F.G);
 })
    PHASE(5, {
        DenseOrder S; S.init(F.ws + WS_YG, (size_t)BM * 16 * 2, F.ws + WS_WGLU, (size_t)BM * SW * 2, T, SW, F.G, (int)blockIdx.x);
        EpiG2 E{(const bf16_t*)(F.ws + WS_YG), args.in[13], (bf16_t*)(F.ws + WS_CAT)};
        gemm_phase<AGroupMajor, EpiG2, DenseOrder, false, false>(F.lds, F.wave, SW, AGroupMajor{}, S, E);
 })
    PHASE(6, {
        DenseOrder S; S.init(F.ws + WS_CAT, (size_t)BM * D * 2, F.ws + WS_WOUT0, (size_t)BM * D * 2, T, D, F.G, (int)blockIdx.x);
        EpiRes E{args.in[0], (float*)(F.ws + WS_XA), (bf16_t*)(F.ws + WS_XB)};
        gemm_phase<ARow, EpiRes, DenseOrder, false, false>(F.lds, F.wave, D, ARow{D * 2}, S, E); })
    PHASE(7, { router_phase(F, args, 0); })
    PHASE(8, { moe_gemms_m1(F, args, 0); })
    PHASE(9, { moe_gemms_m2(F, args, 0); })
    PHASE(10, { combine_phase<0>(F, args); })
    PHASE(11, {
        cumsum_phase(F);
        DenseOrder S; S.init(F.ws + WS_XB, (size_t)BM * D * 2, F.ws + WS_WIN1, (size_t)BM * D * 2, T, 3 * D, F.G, (int)blockIdx.x);
        EpiG4 E{(bf16_t*)(F.ws + WS_QKV), (const float*)(F.ws + WS_R), (float*)(F.ctl + CW_KN2)};
        gemm_phase<ARow, EpiG4, DenseOrder, true, false>(F.lds, F.wave, D, ARow{D * 2}, S, E); })
    PHASE(12, { attn_phase(F, args, lds_raw); })
    PHASE(13, {
        DenseOrder S; S.init(F.ws + WS_CAT, (size_t)BM * D * 2, F.ws + WS_WOUT1, (size_t)BM * D * 2, T, D, F.G, (int)blockIdx.x);
        EpiRes E{(const float*)(F.ws + WS_XBB), (float*)(F.ws + WS_XA), (bf16_t*)(F.ws + WS_XB)};
        gemm_phase<ARow, EpiRes, DenseOrder, false, false>(F.lds, F.wave, D, ARow{D * 2}, S, E); })
    PHASE(14, { router_phase(F, args, 1); filler(F, args, nullptr, 0); })
    PHASE(15, { moe_gemms_m1(F, args, 1); })
    PHASE(16, { moe_gemms_m2(F, args, 1); })
    PHASE(17, { combine_phase<1>(F, args); })
#undef PHASE
#undef IN
#undef BOTH
#undef GRID_BAR
}

static int g_grid = 0;
static bool mk_setup() {
    if (g_grid) return g_grid > 0;
    int dev = 0, cus = 0;
    if (hipGetDevice(&dev) != hipSuccess || hipDeviceGetAttribute(&cus, hipDeviceAttributeMultiprocessorCount, dev) != hipSuccess) { g_grid = -1; return false; }
    if (hipFuncSetAttribute((const void*)mk_fwd, hipFuncAttributeMaxDynamicSharedMemorySize, LDS_BYTES) != hipSuccess) { g_grid = -1; return false; }
    int per_cu = 0;
    (void)hipOccupancyMaxActiveBlocksPerMultiprocessor(&per_cu, (const void*)mk_fwd, NWAVES * 64, LDS_BYTES);
    (void)hipGetLastError();
    if (per_cu < 1) fprintf(stderr, "mk: occupancy query says %d blocks/CU\n", per_cu);
    g_grid = cus;
    return true;
}
static void mk_launch(hipStream_t stream, void* const* d_in, void* d_out, void* d_ws, int lo, int hi, int li, int flags) {
    Args a{};
    for (int i = 0; i < 28; ++i) a.in[i] = (const float*)d_in[i];
    a.out = (float*)d_out; a.ws = (unsigned char*)d_ws; a.ph_lo = lo; a.ph_hi = hi; a.li = li; a.flags = flags;
    hipLaunchKernelGGL(mk_fwd, dim3(g_grid), dim3(NWAVES * 64), LDS_BYTES, stream, a);
}
}

extern "C" void kernel_launch(void* const* d_in, const int* in_sizes, int n_in, void* d_out, int out_size, void* d_ws, size_t ws_size, hipStream_t stream) {
    (void)in_sizes; (void)n_in; (void)out_size;
    if (ws_size < mk::WS_END) { fprintf(stderr, "workspace too small: %zu\n", ws_size); return; }
    if (!mk::mk_setup()) { fprintf(stderr, "mk setup failed\n"); return; }
    (void)hipMemsetAsync((char*)d_ws + mk::WS_CTL, 0, mk::CTL_BYTES, stream);
    mk::mk_launch(stream, d_in, d_out, d_ws, 0, 18, 0, mk::PF_L0 | mk::PF_S5 | mk::PF_L1 | mk::PF_MOE0);
}
```
